# Optimizing an MI355X kernel written in HIP

```python
import jax, jax.numpy as jnp
from jax import lax
import numpy as np

D_MODEL = 1024
BATCH = 16
SEQ = 4096
DEPTH = 4

N_EVEN = (DEPTH + 1) // 2
N_ODD = DEPTH // 2
A_W = D_MODEL // 2
A_HEAD_DIM = 64
A_HEADS = A_W // A_HEAD_DIM
W_LORA = 64
A_LORA = 64
G_LORA = 128
P_A = 3 * A_W + W_LORA + A_LORA + G_LORA
LNX_EPS = 64e-5
B_W = D_MODEL // 2
B_GROUPS = 4
B_GROUP_DIM = B_W // B_GROUPS
CHUNK = 128
P_EVEN = P_A + 2 * B_W
C_W = D_MODEL // 2
CONV_WIDTH = 31
D_W = D_MODEL // 2
POOL_WINDOWS = (2, 4, 8, 16)
POOL_GROUP_DIM = D_W // len(POOL_WINDOWS)
P_ODD = 2 * C_W + D_W
FFN_HIDDEN = ((8 * D_MODEL + 3 * 256 - 1) // (3 * 256)) * 256
RMS_EPS = 1e-5
LN_EPS = 1e-5

kernel_name = "hybrid_rwkv7_gmlp_conformer_pool_trunk"

F32 = jnp.float32


def _rms_norm(x, g):
    x32 = x.astype(F32)
    y = x32 * lax.rsqrt(jnp.mean(jnp.square(x32), -1, keepdims=True) + RMS_EPS) * g
    return y.astype(x.dtype)


def _layer_norm(x, g, b):
    x32 = x.astype(F32)
    mu = jnp.mean(x32, -1, keepdims=True)
    var = jnp.mean(jnp.square(x32 - mu), -1, keepdims=True)
    return ((x32 - mu) * lax.rsqrt(var + LN_EPS) * g + b).astype(x.dtype)


def _rwkv7_scan(r, w, k, v, a, b):
    bsz, _, h, n = r.shape

    def step(state, inp):
        r_t, w_t, k_t, v_t, a_t, b_t = inp
        sa = jnp.einsum('bhvk,bhk->bhv', state, a_t)
        state = (state * w_t[:, :, None, :] + sa[..., None] * b_t[:, :, None, :]
                 + v_t[..., None] * k_t[:, :, None, :])
        y_t = jnp.einsum('bhvk,bhk->bhv', state, r_t)
        return state, y_t

    xs = tuple(jnp.swapaxes(t, 0, 1) for t in (r, w, k, v, a, b))
    s0 = jnp.zeros((bsz, h, n, n), F32)
    _, ys = lax.scan(step, s0, xs)
    return jnp.swapaxes(ys, 0, 1)


def _even_mixer(h, w_in, mu, w0, w_up, a0, a_up, g_up, k_k, k_a, r_k, lnx_g, lnx_b,
                bn_g, bn_b, sp_w, sp_b, w_out):
    bsz, s, _ = h.shape
    proj = h @ w_in
    pa, pb = proj[..., :P_A], proj[..., P_A:]
    shifted = jnp.pad(pa, ((0, 0), (1, 0), (0, 0)))[:, :s]
    pa = pa + (shifted - pa) * mu
    r, k, v, wd, ad, gd = jnp.split(
        pa, [A_W, 2 * A_W, 3 * A_W, 3 * A_W + W_LORA, 3 * A_W + W_LORA + A_LORA], axis=-1)
    w_log = -jax.nn.softplus(-(w0 + jnp.tanh(wd) @ w_up).astype(F32)) - 0.5
    decay = jnp.exp(-jnp.exp(w_log))
    a = jax.nn.sigmoid(a0 + ad @ a_up)
    g = jax.nn.sigmoid(gd) @ g_up
    heads = lambda t: t.reshape(bsz, s, A_HEADS, A_HEAD_DIM).astype(F32)
    kk = heads(k * k_k)
    kk = kk / jnp.maximum(jnp.sqrt(jnp.sum(kk * kk, -1, keepdims=True)), 1e-12)
    k = k * (1 + (a - 1) * k_a)
    rh, kh, vh, ah = heads(r), heads(k), heads(v), heads(a)
    y = _rwkv7_scan(rh, heads(decay), kh, vh, -kk, kk * ah)
    ym = jnp.mean(y, -1, keepdims=True)
    yv = jnp.mean(jnp.square(y - ym), -1, keepdims=True)
    y = ((y - ym) * lax.rsqrt(yv + LNX_EPS)).reshape(bsz, s, A_W) * lnx_g + lnx_b
    bonus = jnp.sum(rh * kh * r_k, -1, keepdims=True) * vh
    y_a = ((y + bonus.reshape(bsz, s, A_W)) * g).astype(h.dtype)
    gb = jax.nn.gelu(pb, approximate=False)
    u, z = gb[..., :B_W], gb[..., B_W:]
    z = _layer_norm(z, bn_g, bn_b)
    zc = z.reshape(bsz, s // CHUNK, CHUNK, B_GROUPS, B_GROUP_DIM)
    mask = jnp.tril(jnp.ones((CHUNK, CHUNK), sp_w.dtype))
    sz = jnp.einsum('gij,bcjgd->bcigd', sp_w * mask, zc) + jnp.transpose(sp_b)[:, :, None]
    y_b = (u * sz.reshape(bsz, s, B_W)).astype(h.dtype)
    return jnp.concatenate([y_a, y_b], axis=-1) @ w_out


def _odd_mixer(h, w_in, conv_w, conv_b, cn_g, cn_b, pool_w, pool_scale, w_out):
    bsz, s, _ = h.shape
    proj = h @ w_in
    cv, cg, d = jnp.split(proj, [C_W, 2 * C_W], axis=-1)
    glu = cv * jax.nn.sigmoid(cg)
    conv = lax.conv_general_dilated(
        glu, conv_w[:, None, :].astype(glu.dtype), window_strides=(1,),
        padding=[(CONV_WIDTH - 1, 0)], dimension_numbers=('NWC', 'WIO', 'NWC'),
        feature_group_count=C_W) + conv_b
    y_c = jax.nn.silu(_layer_norm(conv, cn_g, cn_b))
    d32 = d.astype(F32)
    cs = jnp.cumsum(d32, axis=1)
    t_idx = jnp.arange(s)
    outs = []
    for gi, win in enumerate(POOL_WINDOWS):
        lo, hi = gi * POOL_GROUP_DIM, (gi + 1) * POOL_GROUP_DIM
        c = cs[:, :, lo:hi]
        c_full = jnp.pad(c, ((0, 0), (win, 0), (0, 0)))
        total = c_full[:, win:] - c_full[:, :s]
        count = jnp.minimum(t_idx + 1, win).astype(F32)
        outs.append(total / count[None, :, None] - d32[:, :, lo:hi])
    pooled = jnp.stack(outs, axis=2).astype(h.dtype)
    y_d = jnp.einsum('bsgi,gio->bsgo', pooled, pool_w).reshape(bsz, s, D_W) * pool_scale
    return jnp.concatenate([y_c, y_d.astype(h.dtype)], axis=-1) @ w_out


def _swiglu(h, w_gate, w_up, w_down):
    return (jax.nn.silu(h @ w_gate) * (h @ w_up)) @ w_down


def setup_inputs(seed: int = 0) -> dict:
    key = jax.random.key(seed)
    keys = jax.random.split(key, 40)
    ctr = [0]

    def nk():
        ctr[0] += 1
        return keys[ctr[0] - 1]

    def nrm(shape, scale):
        return jax.random.normal(nk(), shape, F32) * scale

    def unif(shape, lo, hi):
        return jax.random.uniform(nk(), shape, F32, lo, hi)

    NE, NO, D = N_EVEN, N_ODD, D_MODEL
    return {
        "x": nrm((BATCH, SEQ, D), 1.0),
        "mix_norm_g": 1.0 + nrm((DEPTH, D), 0.02),
        "ffn_norm_g": 1.0 + nrm((DEPTH, D), 0.02),
        "final_norm_g": 1.0 + nrm((D,), 0.02),
        "ev_w_in": nrm((NE, D, P_EVEN), D ** -0.5),
        "ev_shift_mu": unif((NE, P_A), 0.0, 1.0),
        "ev_w0": unif((NE, A_W), -6.5, -1.5),
        "ev_w_up": nrm((NE, W_LORA, A_W), 0.5 * W_LORA ** -0.5),
        "ev_a0": nrm((NE, A_W), 0.1),
        "ev_a_up": nrm((NE, A_LORA, A_W), A_LORA ** -0.5),
        "ev_g_up": nrm((NE, G_LORA, A_W), G_LORA ** -0.5),
        "ev_k_k": 0.85 + nrm((NE, A_W), 0.02),
        "ev_k_a": 1.0 + nrm((NE, A_W), 0.02),
        "ev_r_k": nrm((NE, A_HEADS, A_HEAD_DIM), 0.1),
        "ev_lnx_g": 1.0 + nrm((NE, A_W), 0.02),
        "ev_lnx_b": nrm((NE, A_W), 0.02),
        "ev_bnorm_g": 1.0 + nrm((NE, B_W), 0.02),
        "ev_bnorm_b": nrm((NE, B_W), 0.02),
        "ev_spatial_w": nrm((NE, B_GROUPS, CHUNK, CHUNK), CHUNK ** -0.5),
        "ev_spatial_b": 1.0 + nrm((NE, B_GROUPS, CHUNK), 0.1),
        "ev_w_out": nrm((NE, D, D), D ** -0.5),
        "od_w_in": nrm((NO, D, P_ODD), D ** -0.5),
        "od_conv_w": nrm((NO, CONV_WIDTH, C_W), CONV_WIDTH ** -0.5),
        "od_conv_b": nrm((NO, C_W), 0.02),
        "od_cnorm_g": 1.0 + nrm((NO, C_W), 0.02),
        "od_cnorm_b": nrm((NO, C_W), 0.02),
        "od_pool_w": nrm((NO, len(POOL_WINDOWS), POOL_GROUP_DIM, POOL_GROUP_DIM), POOL_GROUP_DIM ** -0.5),
        "od_pool_scale": 1.0 + nrm((NO, D_W), 0.1),
        "od_w_out": nrm((NO, D, D), D ** -0.5),
        "ffn_w_gate": nrm((DEPTH, D, FFN_HIDDEN), D ** -0.5),
        "ffn_w_up": nrm((DEPTH, D, FFN_HIDDEN), D ** -0.5),
        "ffn_w_down": nrm((DEPTH, FFN_HIDDEN, D), FFN_HIDDEN ** -0.5),
    }


def reference(x, mix_norm_g, ffn_norm_g, final_norm_g,
              ev_w_in, ev_shift_mu, ev_w0, ev_w_up, ev_a0, ev_a_up, ev_g_up,
              ev_k_k, ev_k_a, ev_r_k, ev_lnx_g, ev_lnx_b, ev_bnorm_g, ev_bnorm_b,
              ev_spatial_w, ev_spatial_b, ev_w_out,
              od_w_in, od_conv_w, od_conv_b, od_cnorm_g, od_cnorm_b,
              od_pool_w, od_pool_scale, od_w_out,
              ffn_w_gate, ffn_w_up, ffn_w_down):
    h = x
    for layer in range(DEPTH):
        i = layer // 2
        hn = _rms_norm(h, mix_norm_g[layer])
        if layer % 2 == 0:
            mix = _even_mixer(hn, ev_w_in[i], ev_shift_mu[i], ev_w0[i], ev_w_up[i],
                              ev_a0[i], ev_a_up[i], ev_g_up[i], ev_k_k[i], ev_k_a[i],
                              ev_r_k[i], ev_lnx_g[i], ev_lnx_b[i], ev_bnorm_g[i],
                              ev_bnorm_b[i], ev_spatial_w[i], ev_spatial_b[i], ev_w_out[i])
        else:
            mix = _odd_mixer(hn, od_w_in[i], od_conv_w[i], od_conv_b[i], od_cnorm_g[i],
                             od_cnorm_b[i], od_pool_w[i], od_pool_scale[i], od_w_out[i])
        h = h + mix.astype(h.dtype)
        ff = _swiglu(_rms_norm(h, ffn_norm_g[layer]), ffn_w_gate[layer], ffn_w_up[layer],
                     ffn_w_down[layer])
        h = h + ff.astype(h.dtype)
    return _rms_norm(h, final_norm_g)
```

```cpp
#include <hip/hip_runtime.h>
#include <hip/hip_cooperative_groups.h>
#include <cstdio>
#include <cstdint>
namespace pg8 {
#define PG8_LAS __attribute__((address_space(3)))
typedef unsigned short bf16_t;
typedef short bf16x8 __attribute__((ext_vector_type(8)));
typedef float f32x4 __attribute__((ext_vector_type(4)));
typedef unsigned u32x4 __attribute__((ext_vector_type(4)));
constexpr int BM = 256, BK = 64, HALF = 128, HTB = HALF * BK * 2  , STAGE_BYTES = 8 * HTB, NXCD = 8, WGM = 8;

__host__ __device__ __forceinline__ int lds_byte(int r, int c) { const int st = (r >> 4) * 2 + (c >> 5), rr = r & 15, cc = c & 31, ob = rr * 64 + cc * 2; return st * 1024 + (ob ^ (((ob >> 9) & 1) << 5)); }
__host__ __device__ __forceinline__ void stage_rc(int b, int& R, int& C) { const int st = b / 1024, sb = b % 1024, swz = sb ^ (((sb >> 9) & 1) << 5); R = (st >> 1) * 16 + swz / 64; C = (st & 1) * 32 + (swz % 64) / 2; }
__host__ __device__ __forceinline__ int perm32(int rho) { const int n = rho >> 4, i = rho & 15; return 8 * (i >> 2) + 4 * n + (i & 3); }

struct Unit { int pm, pn; };
struct Gemm { const bf16_t* A; const bf16_t* Bt; int M, N, K; };

struct StaticOrder {
    int nM, nN, nwg, G, c;
    __host__ __device__ void init(int M, int N, int G_, int c_) { nM = M / BM; nN = N / BM; nwg = nM * nN; G = G_; c = c_; }
    __host__ __device__ bool next(int i, Unit& u) const {
        const long L = (long)i * G + c; if (L >= nwg) return false;
        int wgid = (int)L; { const int q = nwg / NXCD, r = nwg % NXCD, xcd = wgid % NXCD, off = wgid / NXCD; wgid = (xcd < r ? xcd * (q + 1) : r * (q + 1) + (xcd - r) * q) + off; }
        const int nig = WGM * nN, gid = wgid / nig, fm = gid * WGM, gsz = (nM - fm) < WGM ? (nM - fm) : WGM;
        u.pm = fm + ((wgid % nig) % gsz); u.pn = (wgid % nig) / gsz; return true;
    }
    __device__ __forceinline__ void a_ready(const Unit&) const {}
    __device__ __forceinline__ void done(const Unit&) const {}
};

__device__ __forceinline__ unsigned cvt_pk_bf16(float lo, float hi) { unsigned r; asm volatile("v_cvt_pk_bf16_f32 %0, %1, %2" : "=v"(r) : "v"(lo), "v"(hi)); return r; }
typedef float f32x2 __attribute__((ext_vector_type(2)));
__device__ __forceinline__ f32x2 gelu_pk(f32x2 v) {
    const f32x2 av = __builtin_elementwise_abs(v), d = av * 0.2316418882f + 1.0f;
    f32x2 t; t.x = __builtin_amdgcn_rcpf(d.x); t.y = __builtin_amdgcn_rcpf(d.y);
    f32x2 q = t * 0.5307027145f + (-0.7265760135f); q = q * t + 0.7107068705f; q = q * t + (-0.142248368f); q = q * t + 0.127414796f; q = q * t;
    const f32x2 s = (v * v) * (-0.72134752044f);
    f32x2 e; e.x = __builtin_amdgcn_exp2f(s.x); e.y = __builtin_amdgcn_exp2f(s.y);
    const f32x2 m = v * (q * e), r = v - m;
    f32x2 o; o.x = v.x < 0.f ? m.x : r.x; o.y = v.y < 0.f ? m.y : r.y; return o;
}

struct EpiProj {
    static constexpr bool PERM = true, AFTER_DRAIN = false;
    bf16_t* O; int ldc; int gelu_from;
    __device__ __forceinline__ void operator()(const f32x4 (&acc)[2][2][4][2], const Unit& u, int wr, int wc, int fr, int fq) const {
        const int row0 = u.pm * BM + wr * 64 + fr; const int col0 = u.pn * BM + wc * 32 + 8 * fq; const bool act = u.pn >= gelu_from;
#pragma unroll
        for (int ai = 0; ai < 2; ++ai)
#pragma unroll
            for (int m = 0; m < 4; ++m) { bf16_t* rowp = O + (size_t)(row0 + ai * HALF + m * 16) * ldc + col0;
#pragma unroll
                for (int bj = 0; bj < 2; ++bj) { f32x4 v0 = acc[ai][bj][m][0], v1 = acc[ai][bj][m][1];
                    if (act) { f32x2 a = gelu_pk((f32x2){v0[0], v0[1]}), b = gelu_pk((f32x2){v0[2], v0[3]}), c = gelu_pk((f32x2){v1[0], v1[1]}), d = gelu_pk((f32x2){v1[2], v1[3]});
                        v0 = (f32x4){a.x, a.y, b.x, b.y}; v1 = (f32x4){c.x, c.y, d.x, d.y}; }
                    u32x4 w; w.x = cvt_pk_bf16(v0[0], v0[1]); w.y = cvt_pk_bf16(v0[2], v0[3]); w.z = cvt_pk_bf16(v1[0], v1[1]); w.w = cvt_pk_bf16(v1[2], v1[3]);
                    *(u32x4*)(rowp + bj * HALF) = w; } }
    }
};
template <bool BASE_F32> struct EpiResT {
    static constexpr bool PERM = true, AFTER_DRAIN = false;
    const float* basef; const bf16_t* baseh; bf16_t* hout; int ldc;
    __device__ __forceinline__ void operator()(const f32x4 (&acc)[2][2][4][2], const Unit& u, int wr, int wc, int fr, int fq) const {
        const int row0 = u.pm * BM + wr * 64 + fr, col0 = u.pn * BM + wc * 32 + 8 * fq;
#pragma unroll
        for (int ai = 0; ai < 2; ++ai)
#pragma unroll
            for (int mp = 0; mp < 2; ++mp) {
                if constexpr (BASE_F32) {
                    f32x4 bs[2][2][2];
#pragma unroll
                    for (int mm = 0; mm < 2; ++mm)
#pragma unroll
                        for (int bj = 0; bj < 2; ++bj)
#pragma unroll
                            for (int n = 0; n < 2; ++n) bs[mm][bj][n] = *(const f32x4*)(basef + (size_t)(row0 + ai * HALF + (2 * mp + mm) * 16) * ldc + col0 + bj * HALF + n * 4);
#pragma unroll
                    for (int mm = 0; mm < 2; ++mm)
#pragma unroll
                        for (int bj = 0; bj < 2; ++bj) { const int m = 2 * mp + mm; const f32x4 h0 = bs[mm][bj][0] + acc[ai][bj][m][0], h1 = bs[mm][bj][1] + acc[ai][bj][m][1];
                            u32x4 w; w.x = cvt_pk_bf16(h0[0], h0[1]); w.y = cvt_pk_bf16(h0[2], h0[3]); w.z = cvt_pk_bf16(h1[0], h1[1]); w.w = cvt_pk_bf16(h1[2], h1[3]);
                            *(u32x4*)(hout + (size_t)(row0 + ai * HALF + m * 16) * ldc + col0 + bj * HALF) = w; }
                } else {
                    u32x4 bs[2][2];
#pragma unroll
                    for (int mm = 0; mm < 2; ++mm)
#pragma unroll
                        for (int bj = 0; bj < 2; ++bj) bs[mm][bj] = *(const u32x4*)(baseh + (size_t)(row0 + ai * HALF + (2 * mp + mm) * 16) * ldc + col0 + bj * HALF);
#pragma unroll
                    for (int mm = 0; mm < 2; ++mm)
#pragma unroll
                        for (int bj = 0; bj < 2; ++bj) { const int m = 2 * mp + mm; const u32x4 q = bs[mm][bj]; const f32x4 a0 = acc[ai][bj][m][0], a1 = acc[ai][bj][m][1];
                            u32x4 w;
                            w.x = cvt_pk_bf16(__builtin_bit_cast(float, q.x << 16) + a0[0], __builtin_bit_cast(float, q.x & 0xffff0000u) + a0[1]);
                            w.y = cvt_pk_bf16(__builtin_bit_cast(float, q.y << 16) + a0[2], __builtin_bit_cast(float, q.y & 0xffff0000u) + a0[3]);
                            w.z = cvt_pk_bf16(__builtin_bit_cast(float, q.z << 16) + a1[0], __builtin_bit_cast(float, q.z & 0xffff0000u) + a1[1]);
                            w.w = cvt_pk_bf16(__builtin_bit_cast(float, q.w << 16) + a1[2], __builtin_bit_cast(float, q.w & 0xffff0000u) + a1[3]);
                            *(u32x4*)(hout + (size_t)(row0 + ai * HALF + m * 16) * ldc + col0 + bj * HALF) = w; }
                }
                asm volatile("" ::: "memory"); }
    }
};
template <bool BASE_F32, bool FINAL> struct EpiResX {
    static constexpr bool PERM = true, AFTER_DRAIN = false;
    const float* basef; const bf16_t* baseh; bf16_t* hout; bf16_t* hn; float* outf; const float* gain; int ldc;
    unsigned* xbuf; unsigned* cnt; unsigned target; PG8_LAS unsigned char* lds;
    __device__ __forceinline__ void operator()(f32x4 (&acc)[2][2][4][2], const Unit& u, int wr, int wc, int fr_, int fq_) const {
        int fr = fr_, fq = fq_; asm volatile("" : "+v"(fr), "+v"(fq));
        const int lane = fq * 16 + fr, wid = wr * 4 + wc, tid = wid * 64 + lane;
        PG8_LAS float* P = (PG8_LAS float*)(lds + 131072); PG8_LAS float* S = (PG8_LAS float*)(lds + 131072 + 4096);
        const int row0 = u.pm * BM + wr * 64 + fr, col0 = u.pn * BM + wc * 32 + 8 * fq;
        if constexpr (BASE_F32) {
#pragma unroll
            for (int ai = 0; ai < 2; ++ai)
#pragma unroll
                for (int mp = 0; mp < 2; ++mp) { f32x4 bsf[2][2][2];
#pragma unroll
                    for (int mm = 0; mm < 2; ++mm)
#pragma unroll
                        for (int bj = 0; bj < 2; ++bj) { const size_t off = (size_t)(row0 + ai * HALF + (2 * mp + mm) * 16) * ldc + col0 + bj * HALF; bsf[mm][bj][0] = *(const f32x4*)(basef + off); bsf[mm][bj][1] = *(const f32x4*)(basef + off + 4); }
#pragma unroll
                    for (int mm = 0; mm < 2; ++mm)
#pragma unroll
                        for (int bj = 0; bj < 2; ++bj) { const int m = 2 * mp + mm; acc[ai][bj][m][0] += bsf[mm][bj][0]; acc[ai][bj][m][1] += bsf[mm][bj][1]; }
                    asm volatile("" ::: "memory"); }
        } else {
#pragma unroll
            for (int ai = 0; ai < 2; ++ai) { u32x4 bsh[4][2];
#pragma unroll
                for (int m = 0; m < 4; ++m)
#pragma unroll
                    for (int bj = 0; bj < 2; ++bj) bsh[m][bj] = *(const u32x4*)(baseh + (size_t)(row0 + ai * HALF + m * 16) * ldc + col0 + bj * HALF);
#pragma unroll
                for (int m = 0; m < 4; ++m)
#pragma unroll
                    for (int bj = 0; bj < 2; ++bj) { const u32x4 q = bsh[m][bj];
                        acc[ai][bj][m][0] += (f32x4){__builtin_bit_cast(float, q.x << 16), __builtin_bit_cast(float, q.x & 0xffff0000u), __builtin_bit_cast(float, q.y << 16), __builtin_bit_cast(float, q.y & 0xffff0000u)};
                        acc[ai][bj][m][1] += (f32x4){__builtin_bit_cast(float, q.z << 16), __builtin_bit_cast(float, q.z & 0xffff0000u), __builtin_bit_cast(float, q.w << 16), __builtin_bit_cast(float, q.w & 0xffff0000u)}; }
                asm volatile("" ::: "memory"); }
        }
#pragma unroll
        for (int ai = 0; ai < 2; ++ai)
#pragma unroll
            for (int m = 0; m < 4; ++m) { float ss = 0.f;
#pragma unroll
                for (int bj = 0; bj < 2; ++bj) { const f32x4 h0 = acc[ai][bj][m][0], h1 = acc[ai][bj][m][1];
                    ss += ((h0[0] * h0[0] + h0[1] * h0[1]) + (h0[2] * h0[2] + h0[3] * h0[3])) + ((h1[0] * h1[0] + h1[1] * h1[1]) + (h1[2] * h1[2] + h1[3] * h1[3])); }
                ss += __builtin_bit_cast(float, __builtin_amdgcn_ds_bpermute((lane ^ 16) << 2, __builtin_bit_cast(int, ss)));
                ss += __builtin_bit_cast(float, __builtin_amdgcn_ds_bpermute((lane ^ 32) << 2, __builtin_bit_cast(int, ss)));
                if (fq == 0) P[(ai * HALF + wr * 64 + m * 16 + fr) * 4 + wc] = ss; }
        asm volatile("s_waitcnt lgkmcnt(0)" ::: "memory"); __builtin_amdgcn_s_barrier(); asm volatile("" ::: "memory");
        if (wid < 4) {
            const f32x4 p = *(const PG8_LAS f32x4*)(P + tid * 4); const float bs = (p[0] + p[1]) + (p[2] + p[3]);
            __hip_atomic_store(xbuf + ((size_t)(u.pm * BM + tid) * 4 + u.pn), __builtin_bit_cast(unsigned, bs), __ATOMIC_RELAXED, __HIP_MEMORY_SCOPE_AGENT);
            asm volatile("s_waitcnt vmcnt(0)" ::: "memory");
            if (lane == 0) __hip_atomic_fetch_add(cnt + 64 * u.pm, 1u, __ATOMIC_RELAXED, __HIP_MEMORY_SCOPE_AGENT);
        }
        if (wid == 0) {
            unsigned spins = 0;
            while ((unsigned)__builtin_amdgcn_readfirstlane((int)__hip_atomic_load(cnt + 64 * u.pm, __ATOMIC_RELAXED, __HIP_MEMORY_SCOPE_AGENT)) < target) { __builtin_amdgcn_s_sleep(1); if (++spins > (1u << 21)) break; }
        }
        asm volatile("s_waitcnt vmcnt(0) lgkmcnt(0)" ::: "memory"); __builtin_amdgcn_s_barrier(); asm volatile("" ::: "memory");
        if (wid < 4) {
            const unsigned* slot = xbuf + (size_t)(u.pm * BM + tid) * 4; float s = 0.f;
#pragma unroll
            for (int q = 0; q < 4; ++q) s += __builtin_bit_cast(float, __hip_atomic_load(slot + q, __ATOMIC_RELAXED, __HIP_MEMORY_SCOPE_AGENT));
            S[tid] = __builtin_amdgcn_rsqf(s * (1.0f / 1024.0f) + 1e-5f);
        }
        asm volatile("s_waitcnt vmcnt(0) lgkmcnt(0)" ::: "memory"); __builtin_amdgcn_s_barrier(); asm volatile("" ::: "memory");
        asm volatile("" : "+v"(fr), "+v"(fq));
        const int row0b = u.pm * BM + wr * 64 + fr, col0b = u.pn * BM + wc * 32 + 8 * fq;
        f32x4 gv[2][2];
#pragma unroll
        for (int bj = 0; bj < 2; ++bj) { gv[bj][0] = *(const f32x4*)(gain + col0b + bj * HALF); gv[bj][1] = *(const f32x4*)(gain + col0b + bj * HALF + 4); }
#pragma unroll
        for (int ai = 0; ai < 2; ++ai)
#pragma unroll
            for (int m = 0; m < 4; ++m) { const float r = S[ai * HALF + wr * 64 + m * 16 + fr]; const size_t off = (size_t)(row0b + ai * HALF + m * 16) * ldc + col0b;
#pragma unroll
                for (int bj = 0; bj < 2; ++bj) { const f32x4 h0 = acc[ai][bj][m][0], h1 = acc[ai][bj][m][1]; const f32x4 v0 = h0 * r * gv[bj][0], v1 = h1 * r * gv[bj][1];
                    if constexpr (!FINAL) { u32x4 w; w.x = cvt_pk_bf16(h0[0], h0[1]); w.y = cvt_pk_bf16(h0[2], h0[3]); w.z = cvt_pk_bf16(h1[0], h1[1]); w.w = cvt_pk_bf16(h1[2], h1[3]); *(u32x4*)(hout + off + bj * HALF) = w; }
                    if constexpr (FINAL) { *(f32x4*)(outf + off + bj * HALF) = v0; *(f32x4*)(outf + off + bj * HALF + 4) = v1; }
                    else { u32x4 w; w.x = cvt_pk_bf16(v0[0], v0[1]); w.y = cvt_pk_bf16(v0[2], v0[3]); w.z = cvt_pk_bf16(v1[0], v1[1]); w.w = cvt_pk_bf16(v1[2], v1[3]);
                        *(u32x4*)(hn + off + bj * HALF) = w; } } }
    }
};
struct EpiSwiGLU {
    static constexpr bool PERM = true, AFTER_DRAIN = false;
    bf16_t* O; int ldc;
    __device__ __forceinline__ void operator()(const f32x4 (&acc)[2][2][4][2], const Unit& u, int wr, int wc, int fr, int fq) const {
        const int row0 = u.pm * BM + wr * 64 + fr; const int col0 = u.pn * HALF + wc * 32 + 8 * fq;
#pragma unroll
        for (int ai = 0; ai < 2; ++ai)
#pragma unroll
            for (int m = 0; m < 4; ++m) { bf16_t* rowp = O + (size_t)(row0 + ai * HALF + m * 16) * ldc + col0;
                float o[8];
#pragma unroll
                for (int n = 0; n < 2; ++n)
#pragma unroll
                    for (int j = 0; j < 4; ++j) { const float g = acc[ai][0][m][n][j], up = acc[ai][1][m][n][j];
                        o[n * 4 + j] = g * __builtin_amdgcn_rcpf(1.0f + __builtin_amdgcn_exp2f(-1.44269504f * g)) * up; }
                u32x4 w; w.x = cvt_pk_bf16(o[0], o[1]); w.y = cvt_pk_bf16(o[2], o[3]); w.z = cvt_pk_bf16(o[4], o[5]); w.w = cvt_pk_bf16(o[6], o[7]);
                *(u32x4*)rowp = w; }
    }
};
template <class Epi, class Sched, bool ALIGN_EPI = false, bool SP2 = false>
__device__ __forceinline__ void gemm_phase(PG8_LAS unsigned char* lds, const Gemm g, const Sched& S, const Epi& E) {
    int tid_ = threadIdx.x; asm volatile("" : "+v"(tid_)); const int tid = tid_, wid = __builtin_amdgcn_readfirstlane(tid >> 6), lane = tid & 63, wr = wid >> 2, wc = wid & 3, fr = lane & 15, fq = lane >> 4;
    const int K = g.K, nt = K / BK;
    unsigned voffA[2], voffB[2];
#pragma unroll
    for (int i = 0; i < 2; ++i) { int R, C; stage_rc(tid * 16 + i * 8192, R, C); const int Rb = Epi::PERM ? ((R & ~31) + perm32(R & 31)) : R;
        voffA[i] = (unsigned)(R * K + C) * 2u; voffB[i] = (unsigned)(Rb * K + C) * 2u; }
    const size_t kstep = (size_t)(BK * 2);
    const size_t hstep = (size_t)HALF * K * 2;
    const size_t tstep = 2 * hstep;
    const unsigned ldsw = (unsigned)wid * 1024u;
    const int aoff = lds_byte(wr * 64 + fr, fq * 8), boff = lds_byte(wc * 32 + fr, fq * 8);
#define PG8_SA(b, h) (((b) * 2 + (h)) * HTB)
#define PG8_SB(b, h) ((4 + (b) * 2 + (h)) * HTB)
#define PG8_STAGE(bufoff, gbase, voff) do { _Pragma("unroll") for (int _i = 0; _i < 2; ++_i) \
        __builtin_amdgcn_global_load_lds((const unsigned*)((const char*)(gbase) + (voff)[_i]), (PG8_LAS unsigned*)(lds + (bufoff) + ldsw + _i * 8192), 16, 0, 0); } while (0)
#define PG8_LDA(dst, b, h) do { _Pragma("unroll") for (int m = 0; m < 4; ++m) _Pragma("unroll") for (int k = 0; k < 2; ++k) dst[m][k] = *(const PG8_LAS bf16x8*)(lds + PG8_SA(b, h) + aoff + m * 2048 + k * 1024); } while (0)
#define PG8_LDB(dst, b, h) do { _Pragma("unroll") for (int n = 0; n < 2; ++n) _Pragma("unroll") for (int k = 0; k < 2; ++k) dst[n][k] = *(const PG8_LAS bf16x8*)(lds + PG8_SB(b, h) + boff + n * 2048 + k * 1024); } while (0)
#define PG8_MMA(ai, bj, At, Bt) do { __builtin_amdgcn_s_setprio(1); _Pragma("unroll") for (int m = 0; m < 4; ++m) _Pragma("unroll") for (int n = 0; n < 2; ++n) _Pragma("unroll") for (int k = 0; k < 2; ++k) \
        acc[ai][bj][m][n] = __builtin_amdgcn_mfma_f32_16x16x32_bf16(Bt[n][k], At[m][k], acc[ai][bj][m][n], 0, 0, 0); __builtin_amdgcn_s_setprio(0); } while (0)
#define PG8_WAIT_V(n) asm volatile("s_waitcnt vmcnt(" #n ")" ::: "memory")
#define PG8_WAIT_L(n) asm volatile("s_waitcnt lgkmcnt(" #n ")" ::: "memory")
#define PG8_BAR __builtin_amdgcn_s_barrier()
#define PG8_SCHED __builtin_amdgcn_sched_barrier(0)
    Unit cur, nxt; int ui = 0;
    if (!S.next(0, cur)) return;
    f32x4 acc[2][2][4][2];
#pragma unroll
    for (int a = 0; a < 2; ++a)
#pragma unroll
        for (int b = 0; b < 2; ++b)
#pragma unroll
            for (int m = 0; m < 4; ++m)
#pragma unroll
                for (int n = 0; n < 2; ++n) acc[a][b][m][n] = (f32x4){0.f, 0.f, 0.f, 0.f};
    bf16x8 At[4][2], B0[2][2], B1[2][2];
    const char* cA = (const char*)g.A + (size_t)cur.pm * tstep; const char* cB = (const char*)g.Bt + (size_t)cur.pn * tstep;
    S.a_ready(cur);
    if constexpr (SP2) {
        PG8_STAGE(PG8_SB(0, 0), cB, voffB); PG8_STAGE(PG8_SB(0, 1), cB + hstep, voffB); PG8_STAGE(PG8_SA(0, 0), cA, voffA); PG8_STAGE(PG8_SA(0, 1), cA + hstep, voffA);
        if (wr == 1) PG8_BAR;
        PG8_WAIT_V(2); PG8_BAR;
        PG8_STAGE(PG8_SB(1, 0), cB + kstep, voffB); PG8_STAGE(PG8_SA(1, 0), cA + kstep, voffA); PG8_STAGE(PG8_SB(1, 1), cB + hstep + kstep, voffB);
        PG8_WAIT_V(6); PG8_BAR;
    } else {
        PG8_STAGE(PG8_SB(0, 0), cB, voffB); PG8_STAGE(PG8_SA(0, 0), cA, voffA); PG8_STAGE(PG8_SB(0, 1), cB + hstep, voffB); PG8_STAGE(PG8_SA(0, 1), cA + hstep, voffA);
        if (wr == 1) PG8_BAR;
        PG8_WAIT_V(4); PG8_BAR;
        PG8_STAGE(PG8_SB(1, 0), cB + kstep, voffB); PG8_STAGE(PG8_SA(1, 0), cA + kstep, voffA); PG8_STAGE(PG8_SB(1, 1), cB + hstep + kstep, voffB);
        PG8_WAIT_V(6); PG8_BAR;
    }
    for (;;) {
        const bool has_next = S.next(ui + 1, nxt);
        const char* nA = has_next ? (const char*)g.A + (size_t)nxt.pm * tstep : cA; const char* nB = has_next ? (const char*)g.Bt + (size_t)nxt.pn * tstep : cB;
        for (int t = 0; t < nt; t += 2) {
            const bool last = (t == nt - 2);
            const char* a1 = cA + (size_t)(t + 1) * kstep;
            const char* a2 = last ? nA : cA + (size_t)(t + 2) * kstep; const char* b2 = last ? nB : cB + (size_t)(t + 2) * kstep;
            const char* a3 = a2 + kstep; const char* b3 = b2 + kstep;
            if (last && has_next) S.a_ready(nxt);
            if constexpr (SP2) {
            PG8_LDB(B0, 0, 0); PG8_LDB(B1, 0, 1); PG8_SCHED; PG8_LDA(At, 0, 0); PG8_STAGE(PG8_SA(1, 1), a1 + hstep, voffA);
            PG8_WAIT_V(8); PG8_WAIT_L(0); PG8_BAR; PG8_MMA(0, 0, At, B0); PG8_MMA(0, 1, At, B1); PG8_BAR; PG8_SCHED;
            PG8_LDA(At, 0, 1); PG8_STAGE(PG8_SB(0, 0), b2, voffB); PG8_STAGE(PG8_SB(0, 1), b2 + hstep, voffB); PG8_STAGE(PG8_SA(0, 0), a2, voffA);
            PG8_WAIT_V(8); PG8_WAIT_L(0); PG8_BAR; PG8_MMA(1, 0, At, B0); PG8_MMA(1, 1, At, B1); PG8_BAR; PG8_SCHED;
            PG8_LDB(B0, 1, 0); PG8_LDB(B1, 1, 1); PG8_SCHED; PG8_LDA(At, 1, 0); PG8_STAGE(PG8_SA(0, 1), a2 + hstep, voffA);
            PG8_WAIT_V(8); PG8_WAIT_L(0); PG8_BAR; PG8_MMA(0, 0, At, B0); PG8_MMA(0, 1, At, B1); PG8_BAR; PG8_SCHED;
            PG8_LDA(At, 1, 1); PG8_STAGE(PG8_SB(1, 0), b3, voffB); PG8_STAGE(PG8_SB(1, 1), b3 + hstep, voffB); PG8_STAGE(PG8_SA(1, 0), a3, voffA);
            PG8_WAIT_V(8); PG8_WAIT_L(0); PG8_BAR; PG8_MMA(1, 0, At, B0); PG8_MMA(1, 1, At, B1); PG8_BAR; PG8_SCHED;
            } else {
            PG8_LDB(B0, 0, 0); PG8_SCHED; PG8_LDA(At, 0, 0); PG8_STAGE(PG8_SA(1, 1), a1 + hstep, voffA);
            PG8_WAIT_L(8); PG8_BAR; PG8_WAIT_L(0); PG8_MMA(0, 0, At, B0); PG8_BAR; PG8_SCHED;
            PG8_LDB(B1, 0, 1); PG8_STAGE(PG8_SB(0, 0), b2, voffB);
            PG8_BAR; PG8_WAIT_L(0); PG8_MMA(0, 1, At, B1); PG8_BAR;
            PG8_LDA(At, 0, 1); PG8_STAGE(PG8_SA(0, 0), a2, voffA);
            PG8_BAR; PG8_WAIT_L(0); PG8_MMA(1, 0, At, B0); PG8_BAR; PG8_SCHED;
            PG8_STAGE(PG8_SB(0, 1), b2 + hstep, voffB);
            PG8_WAIT_V(6); PG8_BAR; PG8_MMA(1, 1, At, B1); PG8_BAR;
            PG8_LDB(B0, 1, 0); PG8_SCHED; PG8_LDA(At, 1, 0); PG8_STAGE(PG8_SA(0, 1), a2 + hstep, voffA);
            PG8_WAIT_L(8); PG8_BAR; PG8_WAIT_L(0); PG8_MMA(0, 0, At, B0); PG8_BAR; PG8_SCHED;
            PG8_LDB(B1, 1, 1); PG8_STAGE(PG8_SB(1, 0), b3, voffB);
            PG8_BAR; PG8_WAIT_L(0); PG8_MMA(0, 1, At, B1); PG8_BAR;
            PG8_LDA(At, 1, 1); PG8_STAGE(PG8_SA(1, 0), a3, voffA);
            PG8_BAR; PG8_WAIT_L(0); PG8_MMA(1, 0, At, B0); PG8_BAR; PG8_SCHED;
            PG8_STAGE(PG8_SB(1, 1), b3 + hstep, voffB);
            PG8_WAIT_V(6); PG8_BAR; PG8_MMA(1, 1, At, B1); PG8_BAR;
            }
        }
        if constexpr (ALIGN_EPI) { if (wr == 0) PG8_BAR; }
        if constexpr (!Epi::AFTER_DRAIN) { E(acc, cur, wr, wc, fr, fq); S.done(cur); }
        if (!has_next) break;
#pragma unroll
        for (int a = 0; a < 2; ++a)
#pragma unroll
            for (int b = 0; b < 2; ++b)
#pragma unroll
                for (int m = 0; m < 4; ++m)
#pragma unroll
                    for (int n = 0; n < 2; ++n) acc[a][b][m][n] = (f32x4){0.f, 0.f, 0.f, 0.f};
        cur = nxt; cA = nA; cB = nB; ++ui;
        if constexpr (ALIGN_EPI) { if (wr == 1) PG8_BAR; }
    }
    PG8_WAIT_V(0);
    if constexpr (!ALIGN_EPI) { if (wr == 0) PG8_BAR; }
    PG8_BAR;
    if constexpr (Epi::AFTER_DRAIN) { E.fused(acc, cur, wr, wc, fr, fq, lds, wid, lane); S.done(cur); }
#undef PG8_SA
#undef PG8_SB
#undef PG8_STAGE
#undef PG8_LDA
#undef PG8_LDB
#undef PG8_MMA
#undef PG8_WAIT_V
#undef PG8_WAIT_L
#undef PG8_BAR
#undef PG8_SCHED
}
}

namespace cg = cooperative_groups;
#define LAS __attribute__((address_space(3)))
typedef unsigned short bf16;
typedef float f32x4 __attribute__((ext_vector_type(4)));
typedef float f32x2 __attribute__((ext_vector_type(2)));
typedef short bf16x8 __attribute__((ext_vector_type(8)));
typedef unsigned u32x4 __attribute__((ext_vector_type(4)));
typedef unsigned u32x2 __attribute__((ext_vector_type(2)));

constexpr int NT = 65536, DM = 1024, SEQ = 4096, NB = 16, DEPTH = 4;
constexpr int P_EVEN = 2816, P_A = 1792, P_ODD = 1536, FF = 2816;
constexpr int NTHREADS = 512, NWAVES = 8;
constexpr int LDS_BYTES = 147456;
constexpr int XB_LDS_OFF = LDS_BYTES - 64;

constexpr size_t MiB = 1u << 20;
constexpr size_t WS_EVIN = 0;
constexpr size_t WS_ODIN = 11 * MiB;
constexpr size_t WS_WOUT = 17 * MiB;
constexpr size_t WS_GU   = 25 * MiB;
constexpr size_t WS_DN   = 69 * MiB;
constexpr size_t WS_SPW  = 91 * MiB;
constexpr size_t WS_GUPT = WS_SPW + 256 * 1024;
constexpr size_t WS_WUPT = WS_GUPT + 256 * 1024;
constexpr size_t WS_AUPT = WS_WUPT + 128 * 1024;
constexpr size_t WS_BON  = 92 * MiB;
constexpr size_t WS_HN   = 96 * MiB;
constexpr size_t WS_PROJ = 224 * MiB;
constexpr size_t WS_YCAT = 576 * MiB;
constexpr size_t WS_YS   = 704 * MiB;
constexpr size_t WS_H    = 832 * MiB;
constexpr size_t WS_CTL  = 960 * MiB;
constexpr size_t WS_CNT  = WS_CTL + 16384;
constexpr size_t WS_XB   = WS_CTL + 262144;
constexpr size_t WS_END  = 963 * MiB;

struct Args { const float* in[32]; float* out; unsigned char* ws; };

__device__ __forceinline__ unsigned f2bf(float f) { unsigned u = __builtin_bit_cast(unsigned, f); return (u + 0x7fffu + ((u >> 16) & 1u)) >> 16; }
__device__ __forceinline__ unsigned pk2(float lo, float hi) { unsigned r; asm volatile("v_cvt_pk_bf16_f32 %0, %1, %2" : "=v"(r) : "v"(lo), "v"(hi)); return r; }
__device__ __forceinline__ float bflo(unsigned w) { return __builtin_bit_cast(float, w << 16); }
__device__ __forceinline__ float bfhi(unsigned w) { return __builtin_bit_cast(float, w & 0xffff0000u); }
__device__ __forceinline__ float bf1(bf16 b) { return __builtin_bit_cast(float, ((unsigned)b) << 16); }
__device__ __forceinline__ float sigmoidf_(float x) { return __builtin_amdgcn_rcpf(1.0f + __builtin_amdgcn_exp2f(-1.44269504f * x)); }

template <int CTRL> __device__ __forceinline__ float dppf(float x) { const int v = __builtin_bit_cast(int, x); return __builtin_bit_cast(float, __builtin_amdgcn_update_dpp(v, v, CTRL, 0xF, 0xF, true)); }
__device__ __forceinline__ float sum8(float x)  { x += dppf<0xB1>(x); x += dppf<0x4E>(x); x += dppf<0x141>(x); return x; }
__device__ __forceinline__ float sum16(float x) { x += dppf<0xB1>(x); x += dppf<0x4E>(x); x += dppf<0x141>(x); x += dppf<0x140>(x); return x; }
__device__ __forceinline__ float rdl(float x, int l) { return __builtin_bit_cast(float, __builtin_amdgcn_readlane(__builtin_bit_cast(int, x), l)); }
__device__ __forceinline__ float wave_sum(float v) { v = sum16(v); return (rdl(v, 0) + rdl(v, 16)) + (rdl(v, 32) + rdl(v, 48)); }
__device__ __forceinline__ float shx(float v, int lane, int o) { return __builtin_bit_cast(float, __builtin_amdgcn_ds_bpermute((lane ^ o) << 2, __builtin_bit_cast(int, v))); }
#define LDS_WAIT() asm volatile("s_waitcnt lgkmcnt(0)" ::: "memory")

__device__ __forceinline__ void transpose_item(const float* W, int ldw, int k0, int n0, bf16* WT, int ldt, int drow0, LAS float* scr, int lane) {
#pragma unroll 8
    for (int i = 0; i < 32; ++i) { const int kk = 2 * i + (lane >> 5); scr[kk * 33 + (lane & 31)] = W[(size_t)(k0 + kk) * ldw + n0 + (lane & 31)]; }
    LDS_WAIT(); asm volatile("" ::: "memory");
    const int c = lane & 7;
#pragma unroll
    for (int j = 0; j < 4; ++j) { const int n = (lane >> 3) + 8 * j; const LAS float* s = scr + (8 * c) * 33 + n;
        u32x4 o; o.x = pk2(s[0 * 33], s[1 * 33]); o.y = pk2(s[2 * 33], s[3 * 33]); o.z = pk2(s[4 * 33], s[5 * 33]); o.w = pk2(s[6 * 33], s[7 * 33]);
        *(u32x4*)(WT + (size_t)(drow0 + n) * ldt + k0 + 8 * c) = o; }
    LDS_WAIT(); asm volatile("" ::: "memory");
}

__device__ __forceinline__ void prep_phase(const Args& a, LAS unsigned char* lds) {
    int tid_ = threadIdx.x; asm volatile("" : "+v"(tid_)); const int tid = tid_, lane = tid & 63, wave = tid >> 6;
    LAS float* scr = (LAS float*)(lds + wave * 8704);
    const int gw = blockIdx.x * NWAVES + wave, NGW = gridDim.x * NWAVES;
    unsigned char* ws = a.ws;
    constexpr int I_EVIN = 16 * 88, I_ODIN = 16 * 48, I_EVO = 16 * 32, I_ODO = 8 * 32, I_GU = 16 * 88, I_DN = 44 * 32, I_LW = 16, I_LG = 32;
    constexpr int NITEMS = 2 * I_EVIN + 2 * I_ODIN + 2 * I_EVO + 2 * I_ODO + 8 * I_GU + 4 * I_DN + 4 * I_LW + 2 * I_LG;
    for (int it = gw; it < NITEMS; it += NGW) {
        int r = it;
        if (r < 2 * I_EVIN) { const int i = r / I_EVIN; r %= I_EVIN; const int kb = r / 88, nb = r % 88;
            transpose_item(a.in[4] + (size_t)i * DM * P_EVEN, P_EVEN, kb * 64, nb * 32, (bf16*)(ws + WS_EVIN) + (size_t)i * P_EVEN * DM, DM, nb * 32, scr, lane); continue; } r -= 2 * I_EVIN;
        if (r < 2 * I_ODIN) { const int i = r / I_ODIN; r %= I_ODIN; const int kb = r / 48, nb = r % 48;
            transpose_item(a.in[21] + (size_t)i * DM * P_ODD, P_ODD, kb * 64, nb * 32, (bf16*)(ws + WS_ODIN) + (size_t)i * P_ODD * DM, DM, nb * 32, scr, lane); continue; } r -= 2 * I_ODIN;
        if (r < 2 * I_EVO) { const int i = r / I_EVO; r %= I_EVO; const int kb = r / 32, nb = r % 32;
            transpose_item(a.in[20] + (size_t)i * DM * DM, DM, kb * 64, nb * 32, (bf16*)(ws + WS_WOUT) + (size_t)(2 * i) * DM * DM, DM, nb * 32, scr, lane); continue; } r -= 2 * I_EVO;
        if (r < 2 * I_ODO) { const int i = r / I_ODO; r %= I_ODO; const int kb = r / 32, nb = r % 32;
            transpose_item(a.in[28] + (size_t)i * DM * DM, DM, kb * 64, nb * 32, (bf16*)(ws + WS_WOUT) + (size_t)(2 * i + 1) * DM * DM, DM, nb * 32, scr, lane); continue; } r -= 2 * I_ODO;
        if (r < 8 * I_GU) { const int l = r / (2 * I_GU); r %= 2 * I_GU; const int up = r / I_GU; r %= I_GU; const int kb = r / 88, nb = r % 88; const int n0 = nb * 32;
            transpose_item((up ? a.in[30] : a.in[29]) + (size_t)l * DM * FF, FF, kb * 64, n0, (bf16*)(ws + WS_GU) + (size_t)l * 2 * FF * DM, DM, (n0 >> 7) * 256 + (n0 & 127) + up * 128, scr, lane); continue; } r -= 8 * I_GU;
        if (r < 4 * I_DN) { const int l = r / I_DN; r %= I_DN; const int kb = r / 32, nb = r % 32;
            transpose_item(a.in[31] + (size_t)l * FF * DM, DM, kb * 64, nb * 32, (bf16*)(ws + WS_DN) + (size_t)l * DM * FF, FF, nb * 32, scr, lane); continue; } r -= 4 * I_DN;
        if (r < 4 * I_LW) { const int which = r / (2 * I_LW); r %= 2 * I_LW; const int i = r / I_LW; const int nb = r % I_LW;
            transpose_item((which ? a.in[9] : a.in[7]) + (size_t)i * 64 * 512, 512, 0, nb * 32, (bf16*)(ws + (which ? WS_AUPT : WS_WUPT)) + (size_t)i * 512 * 64, 64, nb * 32, scr, lane); continue; } r -= 4 * I_LW;
        { const int i = r / I_LG; r %= I_LG; const int kb = r / 16, nb = r % 16;
            transpose_item(a.in[10] + (size_t)i * 128 * 512, 512, kb * 64, nb * 32, (bf16*)(ws + WS_GUPT) + (size_t)i * 512 * 128, 128, nb * 32, scr, lane); }
    }
    const int gt = blockIdx.x * NTHREADS + tid, NGT = gridDim.x * NTHREADS;
    for (int e = gt; e < 2 * 4 * 128 * 128; e += NGT) { const int j = e & 127, i = (e >> 7) & 127; const float v = (j <= i) ? a.in[18][e] : 0.f; ((bf16*)(ws + WS_SPW))[e] = (bf16)f2bf(v); }
    for (int e = gt; e < 2 * 1024 * 4 * 16; e += NGT) {
        const int o = e & 1023, ib = (e >> 10) & 15, g = (e >> 14) & 3, i = e >> 16;
        const float* pw = a.in[26] + ((size_t)(i * 4 + g) * 128 + ib * 8) * 128; const float* sc = a.in[27] + i * 512 + g * 128; const float* wo = a.in[28] + (size_t)i * DM * DM + (size_t)(512 + g * 128) * DM + o;
        float acc[8];
#pragma unroll
        for (int q = 0; q < 8; ++q) acc[q] = 0.f;
        for (int j = 0; j < 128; ++j) { const float wv = wo[(size_t)j * DM] * sc[j];
#pragma unroll
            for (int q = 0; q < 8; ++q) acc[q] += pw[q * 128 + j] * wv; }
        u32x4 w; w.x = pk2(acc[0], acc[1]); w.y = pk2(acc[2], acc[3]); w.z = pk2(acc[4], acc[5]); w.w = pk2(acc[6], acc[7]);
        *(u32x4*)((bf16*)(ws + WS_WOUT) + (size_t)(2 * i + 1) * DM * DM + (size_t)o * DM + 512 + g * 128 + ib * 8) = w;
    }
}

__device__ __forceinline__ void rmsnorm_phase(const float* __restrict__ xin, const bf16* __restrict__ hb, const float* __restrict__ g, bf16* __restrict__ hn, bf16* __restrict__ hstream) {
    int tid_ = threadIdx.x; asm volatile("" : "+v"(tid_)); const int lane = tid_ & 63, wave = tid_ >> 6; const int gw = blockIdx.x * NWAVES + wave, NGW = gridDim.x * NWAVES;
    f32x4 gv[4];
#pragma unroll
    for (int j = 0; j < 4; ++j) gv[j] = ((const f32x4*)g)[lane + 64 * j];
    if (xin) {
        for (int m = gw; m < NT; m += NGW) {
            f32x4 v[4]; float s = 0.f; const f32x4* xr = (const f32x4*)(xin + (size_t)m * DM) + lane;
#pragma unroll
            for (int j = 0; j < 4; ++j) v[j] = xr[64 * j];
#pragma unroll
            for (int j = 0; j < 4; ++j) s += (v[j].x * v[j].x + v[j].y * v[j].y) + (v[j].z * v[j].z + v[j].w * v[j].w);
            const float r = 1.0f / sqrtf(wave_sum(s) * (1.f / DM) + 1e-5f);
            u32x2* o8 = (u32x2*)(hn + (size_t)m * DM) + lane; u32x2* s8 = (u32x2*)(hstream + (size_t)m * DM) + lane;
#pragma unroll
            for (int j = 0; j < 4; ++j) { u32x2 w; w.x = pk2(v[j].x * r * gv[j].x, v[j].y * r * gv[j].y); w.y = pk2(v[j].z * r * gv[j].z, v[j].w * r * gv[j].w); o8[64 * j] = w;
                u32x2 q; q.x = pk2(v[j].x, v[j].y); q.y = pk2(v[j].z, v[j].w); s8[64 * j] = q; }
        }
    } else {
        for (int m = gw; m < NT; m += 4 * NGW) {
            u32x2 w[4][4];
#pragma unroll
            for (int q = 0; q < 4; ++q) { const u32x2* xr = (const u32x2*)(hb + (size_t)(m + q * NGW) * DM) + lane;
#pragma unroll
                for (int j = 0; j < 4; ++j) w[q][j] = (m + q * NGW < NT) ? xr[64 * j] : (u32x2){0u, 0u}; }
#pragma unroll
            for (int q = 0; q < 4; ++q) { f32x4 v[4]; float s = 0.f;
#pragma unroll
                for (int j = 0; j < 4; ++j) { v[j] = (f32x4){bflo(w[q][j].x), bfhi(w[q][j].x), bflo(w[q][j].y), bfhi(w[q][j].y)}; s += (v[j].x * v[j].x + v[j].y * v[j].y) + (v[j].z * v[j].z + v[j].w * v[j].w); }
                const float r = 1.0f / sqrtf(wave_sum(s) * (1.f / DM) + 1e-5f);
                u32x2* o8 = (u32x2*)(hn + (size_t)(m + q * NGW) * DM) + lane;
#pragma unroll
                for (int j = 0; j < 4; ++j) { u32x2 o; o.x = pk2(v[j].x * r * gv[j].x, v[j].y * r * gv[j].y); o.y = pk2(v[j].z * r * gv[j].z, v[j].w * r * gv[j].w); if (m + q * NGW < NT) o8[64 * j] = o; } }
        }
    }
}
__device__ __forceinline__ void final_norm_phase(const bf16* hb, float* out, const float* g) {
    int tid_ = threadIdx.x; asm volatile("" : "+v"(tid_)); const int lane = tid_ & 63, wave = tid_ >> 6; const int gw = blockIdx.x * NWAVES + wave, NGW = gridDim.x * NWAVES;
    f32x4 gv[4];
#pragma unroll
    for (int j = 0; j < 4; ++j) gv[j] = ((const f32x4*)g)[lane + 64 * j];
    for (int m = gw; m < NT; m += NGW) {
        const u32x2* xr = (const u32x2*)(hb + (size_t)m * DM) + lane; f32x4 v[4]; float s = 0.f;
#pragma unroll
        for (int j = 0; j < 4; ++j) { const u32x2 w = xr[64 * j]; v[j] = (f32x4){bflo(w.x), bfhi(w.x), bflo(w.y), bfhi(w.y)}; s += (v[j].x * v[j].x + v[j].y * v[j].y) + (v[j].z * v[j].z + v[j].w * v[j].w); }
        const float r = 1.0f / sqrtf(wave_sum(s) * (1.f / DM) + 1e-5f);
        f32x4* orow = (f32x4*)(out + (size_t)m * DM) + lane;
#pragma unroll
        for (int j = 0; j < 4; ++j) orow[64 * j] = v[j] * r * gv[j];
    }
}

constexpr int SC_L = 32;
constexpr int SB_R = 0, SB_W = 8192, SB_K = 16384, SB_V = 24576, SB_KK = 32768, SB_B = 40960, SB_SIZE = 49152;
constexpr int SC_KRAW = 2 * SB_SIZE;
constexpr int SC_TW = SC_KRAW + 8192, SC_AD = SC_TW + 32 * 144;
constexpr int SC_WUP = SC_AD + 32 * 144, SC_AUP = SC_WUP + 64 * 144;
constexpr int SC_Y = SC_AUP + 64 * 144;
constexpr int SC_BON = SC_Y + 2 * 4096;
constexpr int SC_CNT = SC_BON + 512;
static_assert(SC_CNT + 16 <= LDS_BYTES, "scan LDS");

#define LERP1(c, p, m) ((c) + ((p) - (c)) * (m))
struct StepVec { f32x4 kA, kB, wA, wB, bA, bB, cA, cB, rA, rB; float vv; };
__device__ __forceinline__ void unpack8(const u32x4 w, float (&x)[8]) { x[0] = bflo(w.x); x[1] = bfhi(w.x); x[2] = bflo(w.y); x[3] = bfhi(w.y); x[4] = bflo(w.z); x[5] = bfhi(w.z); x[6] = bflo(w.w); x[7] = bfhi(w.w); }

__device__ __forceinline__ void scan_phase(const Args& a, int li, LAS unsigned char* lds) {
    unsigned char* wsl = a.ws; asm volatile("" : "+s"(wsl));
    int tid_ = threadIdx.x; asm volatile("" : "+v"(tid_)); const int tid = tid_, lane = tid & 63, wave = __builtin_amdgcn_readfirstlane(tid >> 6);
    const bf16* proj = (const bf16*)(wsl + WS_PROJ); float* ys = (float*)(wsl + WS_YS); float* bong = (float*)(wsl + WS_BON);
    const float* mu = a.in[5] + li * P_A; const float* w0 = a.in[6] + li * 512; const float* a0 = a.in[8] + li * 512;
    const float* k_k = a.in[11] + li * 512; const float* k_a = a.in[12] + li * 512; const float* r_k = a.in[13] + li * 512;
    for (int unit = blockIdx.x; unit < 256; unit += gridDim.x) {
        const int half = unit & 1, bh = unit >> 1, h = bh & 7, b = bh >> 3;
        { const int row = tid >> 3, seg = tid & 7;
          *(LAS u32x4*)(lds + SC_WUP + row * 144 + seg * 16) = *(const u32x4*)((const bf16*)(wsl + WS_WUPT) + (size_t)li * 512 * 64 + (size_t)(64 * h + row) * 64 + seg * 8);
          *(LAS u32x4*)(lds + SC_AUP + row * 144 + seg * 16) = *(const u32x4*)((const bf16*)(wsl + WS_AUPT) + (size_t)li * 512 * 64 + (size_t)(64 * h + row) * 64 + seg * 8);
          if (tid == 0) *(LAS unsigned*)(lds + SC_CNT) = 0u; }
        __syncthreads();
        if (wave >= 4) {
            const int pw = wave - 4, tb = pw >> 1, jh = pw & 1, ptid = tid - 256;
            const int tl = lane >> 3, q8 = lane & 7; const int t1 = pw * 8 + tl;
            const int cR = 64 * h + 8 * q8, cK = 512 + cR, cV = 1024 + cR, cWD = 1536 + 8 * q8, cAD = 1600 + 8 * q8;
            const int n2 = lane & 15, q2 = lane >> 4; const int t2 = tb * 16 + n2;
            u32x4 cur[5], prv[5];
#define SC_FETCH(cc_) do { const int p0_ = (cc_) * SC_L; const bf16* projc = proj; asm volatile("" : "+s"(projc)); const bf16* rp = projc + ((size_t)b * SEQ + p0_ + t1) * P_EVEN; \
                cur[0] = *(const u32x4*)(rp + cR); cur[1] = *(const u32x4*)(rp + cK); cur[2] = *(const u32x4*)(rp + cV); cur[3] = *(const u32x4*)(rp + cWD); cur[4] = *(const u32x4*)(rp + cAD); \
                _Pragma("unroll") for (int g = 0; g < 5; ++g) prv[g] = (u32x4){0u, 0u, 0u, 0u}; \
                if (p0_ + t1 > 0) { const bf16* pp = rp - P_EVEN; prv[0] = *(const u32x4*)(pp + cR); prv[1] = *(const u32x4*)(pp + cK); prv[2] = *(const u32x4*)(pp + cV); prv[3] = *(const u32x4*)(pp + cWD); prv[4] = *(const u32x4*)(pp + cAD); } } while (0)
            SC_FETCH(0);
            for (int cc = 0; cc <= SEQ / SC_L; ++cc) {
                if (cc < SEQ / SC_L) {
                    const int bo = (cc & 1) * SB_SIZE; const int t = t1;
                    { float c8[8], p8[8], o[8], m8[8], kk8[8];
                        { const f32x4 m0_ = *(const f32x4*)(mu + cR), m1_ = *(const f32x4*)(mu + cR + 4); m8[0] = m0_.x; m8[1] = m0_.y; m8[2] = m0_.z; m8[3] = m0_.w; m8[4] = m1_.x; m8[5] = m1_.y; m8[6] = m1_.z; m8[7] = m1_.w; }
                        unpack8(cur[0], c8); unpack8(prv[0], p8);
#pragma unroll
                        for (int e = 0; e < 8; ++e) o[e] = LERP1(c8[e], p8[e], m8[e]);
                        *(LAS f32x4*)(lds + bo + SB_R + t * 256 + q8 * 32) = (f32x4){o[0], o[1], o[2], o[3]}; *(LAS f32x4*)(lds + bo + SB_R + t * 256 + q8 * 32 + 16) = (f32x4){o[4], o[5], o[6], o[7]};
                        { const f32x4 m0_ = *(const f32x4*)(mu + cV), m1_ = *(const f32x4*)(mu + cV + 4); m8[0] = m0_.x; m8[1] = m0_.y; m8[2] = m0_.z; m8[3] = m0_.w; m8[4] = m1_.x; m8[5] = m1_.y; m8[6] = m1_.z; m8[7] = m1_.w; }
                        unpack8(cur[2], c8); unpack8(prv[2], p8);
#pragma unroll
                        for (int e = 0; e < 8; ++e) o[e] = LERP1(c8[e], p8[e], m8[e]);
                        *(LAS f32x4*)(lds + bo + SB_V + t * 256 + q8 * 32) = (f32x4){o[0], o[1], o[2], o[3]}; *(LAS f32x4*)(lds + bo + SB_V + t * 256 + q8 * 32 + 16) = (f32x4){o[4], o[5], o[6], o[7]};
                        { const f32x4 m0_ = *(const f32x4*)(mu + cK), m1_ = *(const f32x4*)(mu + cK + 4); m8[0] = m0_.x; m8[1] = m0_.y; m8[2] = m0_.z; m8[3] = m0_.w; m8[4] = m1_.x; m8[5] = m1_.y; m8[6] = m1_.z; m8[7] = m1_.w; } { const f32x4 m0_ = *(const f32x4*)(k_k + cR), m1_ = *(const f32x4*)(k_k + cR + 4); kk8[0] = m0_.x; kk8[1] = m0_.y; kk8[2] = m0_.z; kk8[3] = m0_.w; kk8[4] = m1_.x; kk8[5] = m1_.y; kk8[6] = m1_.z; kk8[7] = m1_.w; }
                        unpack8(cur[1], c8); unpack8(prv[1], p8); float ss = 0.f;
#pragma unroll
                        for (int e = 0; e < 8; ++e) { o[e] = LERP1(c8[e], p8[e], m8[e]); c8[e] = o[e] * kk8[e]; ss += c8[e] * c8[e]; }
                        *(LAS f32x4*)(lds + SC_KRAW + t * 256 + q8 * 32) = (f32x4){o[0], o[1], o[2], o[3]}; *(LAS f32x4*)(lds + SC_KRAW + t * 256 + q8 * 32 + 16) = (f32x4){o[4], o[5], o[6], o[7]};
                        ss = sum8(ss); const float inv = 1.0f / fmaxf(sqrtf(ss), 1e-12f);
                        *(LAS f32x4*)(lds + bo + SB_KK + t * 256 + q8 * 32) = (f32x4){c8[0] * inv, c8[1] * inv, c8[2] * inv, c8[3] * inv}; *(LAS f32x4*)(lds + bo + SB_KK + t * 256 + q8 * 32 + 16) = (f32x4){c8[4] * inv, c8[5] * inv, c8[6] * inv, c8[7] * inv};
                        { const f32x4 m0_ = *(const f32x4*)(mu + cWD), m1_ = *(const f32x4*)(mu + cWD + 4); m8[0] = m0_.x; m8[1] = m0_.y; m8[2] = m0_.z; m8[3] = m0_.w; m8[4] = m1_.x; m8[5] = m1_.y; m8[6] = m1_.z; m8[7] = m1_.w; }
                        unpack8(cur[3], c8); unpack8(prv[3], p8);
#pragma unroll
                        for (int e = 0; e < 8; ++e) { const float xw = LERP1(c8[e], p8[e], m8[e]); o[e] = 1.0f - 2.0f * __builtin_amdgcn_rcpf(1.0f + __builtin_amdgcn_exp2f(2.88539008f * xw)); }
                        { u32x4 w; w.x = pk2(o[0], o[1]); w.y = pk2(o[2], o[3]); w.z = pk2(o[4], o[5]); w.w = pk2(o[6], o[7]); *(LAS u32x4*)(lds + SC_TW + t * 144 + q8 * 16) = w; }
                        { const f32x4 m0_ = *(const f32x4*)(mu + cAD), m1_ = *(const f32x4*)(mu + cAD + 4); m8[0] = m0_.x; m8[1] = m0_.y; m8[2] = m0_.z; m8[3] = m0_.w; m8[4] = m1_.x; m8[5] = m1_.y; m8[6] = m1_.z; m8[7] = m1_.w; }
                        unpack8(cur[4], c8); unpack8(prv[4], p8);
#pragma unroll
                        for (int e = 0; e < 8; ++e) o[e] = LERP1(c8[e], p8[e], m8[e]);
                        { u32x4 w; w.x = pk2(o[0], o[1]); w.y = pk2(o[2], o[3]); w.z = pk2(o[4], o[5]); w.w = pk2(o[6], o[7]); *(LAS u32x4*)(lds + SC_AD + t * 144 + q8 * 16) = w; } }
                    if (cc + 1 < SEQ / SC_L) SC_FETCH(cc + 1);
                    LDS_WAIT();
                    if (lane == 0) __hip_atomic_fetch_add((LAS unsigned*)(lds + SC_CNT), 1u, __ATOMIC_RELAXED, __HIP_MEMORY_SCOPE_WORKGROUP);
                    while (__hip_atomic_load((LAS unsigned*)(lds + SC_CNT), __ATOMIC_RELAXED, __HIP_MEMORY_SCOPE_WORKGROUP) < 4u * (unsigned)(cc + 1)) __builtin_amdgcn_s_sleep(1);
                    asm volatile("" ::: "memory");
                    float bp = 0.f;
#pragma unroll
                    for (int jbi = 0; jbi < 2; ++jbi) { const int jb = 2 * jh + jbi, j2 = jb * 16 + 4 * q2;
                        f32x4 accw = {0.f, 0.f, 0.f, 0.f}, acca = {0.f, 0.f, 0.f, 0.f};
#pragma unroll
                        for (int ks = 0; ks < 2; ++ks) {
                            const bf16x8 Aw = *(const LAS bf16x8*)(lds + SC_WUP + (jb * 16 + n2) * 144 + (8 * q2 + 32 * ks) * 2), Aa = *(const LAS bf16x8*)(lds + SC_AUP + (jb * 16 + n2) * 144 + (8 * q2 + 32 * ks) * 2);
                            const bf16x8 Bw = *(const LAS bf16x8*)(lds + SC_TW + t2 * 144 + (8 * q2 + 32 * ks) * 2), Ba = *(const LAS bf16x8*)(lds + SC_AD + t2 * 144 + (8 * q2 + 32 * ks) * 2);
                            accw = __builtin_amdgcn_mfma_f32_16x16x32_bf16(Aw, Bw, accw, 0, 0, 0); acca = __builtin_amdgcn_mfma_f32_16x16x32_bf16(Aa, Ba, acca, 0, 0, 0); }
                        const f32x4 w0v = *(const f32x4*)(w0 + 64 * h + j2), a0v = *(const f32x4*)(a0 + 64 * h + j2), kav = *(const f32x4*)(k_a + 64 * h + j2), rkv = *(const f32x4*)(r_k + 64 * h + j2);
                        const f32x4 kraw = *(const LAS f32x4*)(lds + SC_KRAW + t2 * 256 + j2 * 4), kkn = *(const LAS f32x4*)(lds + bo + SB_KK + t2 * 256 + j2 * 4), rr = *(const LAS f32x4*)(lds + bo + SB_R + t2 * 256 + j2 * 4);
                        f32x4 dec, bb, km;
#pragma unroll
                        for (int e = 0; e < 4; ++e) { const float wp = w0v[e] + accw[e]; dec[e] = __expf(-0.60653066f * sigmoidf_(wp));
                            const float av = sigmoidf_(a0v[e] + acca[e]); km[e] = kraw[e] * (1.0f + (av - 1.0f) * kav[e]); bb[e] = kkn[e] * av; bp += rr[e] * km[e] * rkv[e]; }
                        *(LAS f32x4*)(lds + bo + SB_W + t2 * 256 + j2 * 4) = dec; *(LAS f32x4*)(lds + bo + SB_B + t2 * 256 + j2 * 4) = bb; *(LAS f32x4*)(lds + bo + SB_K + t2 * 256 + j2 * 4) = km; }
                    bp += shx(bp, lane, 16); bp += shx(bp, lane, 32);
                    if (lane < 16) *(LAS float*)(lds + SC_BON + (cc & 1) * 256 + t2 * 8 + jh * 4) = bp;
                }
                if (cc >= 2) { const int pc = cc - 2; const size_t growp = (size_t)b * SEQ + pc * SC_L; const int t = ptid >> 3, seg = ptid & 7;
                    *(f32x4*)(ys + (growp + t) * 512 + 64 * h + 32 * half + 4 * seg) = *(const LAS f32x4*)(lds + SC_Y + (pc & 1) * 4096 + t * 128 + seg * 16); }
                if (cc >= 1 && half == 0 && ptid < 32) { const int pc = cc - 1; const f32x2 bq = *(const LAS f32x2*)(lds + SC_BON + (pc & 1) * 256 + ptid * 8);
                    bong[((size_t)b * SEQ + pc * SC_L + ptid) * 8 + h] = bq.x + bq.y; }
                __syncthreads();
            }
        } else {
            __builtin_amdgcn_s_setprio(3);
            const int rl = wave * 8 + (lane >> 3), cgp = lane & 7, rowg = half * 32 + rl;
            f32x2 s0 = {0.f, 0.f}, s1 = {0.f, 0.f}, s2 = {0.f, 0.f}, s3 = {0.f, 0.f};
            __syncthreads();
            for (int c = 0; c < SEQ / SC_L; ++c) {
                const int bo = (c & 1) * SB_SIZE; const LAS unsigned char* vb = lds + bo + cgp * 32; const LAS unsigned char* vrow = lds + bo + SB_V + rowg * 4;
#define SC_LOADV(V, t) do { V.kA = *(const LAS f32x4*)(vb + SB_KK + (t) * 256); V.kB = *(const LAS f32x4*)(vb + SB_KK + (t) * 256 + 16); V.wA = *(const LAS f32x4*)(vb + SB_W + (t) * 256); V.wB = *(const LAS f32x4*)(vb + SB_W + (t) * 256 + 16); \
        V.bA = *(const LAS f32x4*)(vb + SB_B + (t) * 256); V.bB = *(const LAS f32x4*)(vb + SB_B + (t) * 256 + 16); V.cA = *(const LAS f32x4*)(vb + SB_K + (t) * 256); V.cB = *(const LAS f32x4*)(vb + SB_K + (t) * 256 + 16); \
        V.rA = *(const LAS f32x4*)(vb + SB_R + (t) * 256); V.rB = *(const LAS f32x4*)(vb + SB_R + (t) * 256 + 16); V.vv = *(const LAS float*)(vrow + (t) * 256); } while (0)
#define SB_ __builtin_amdgcn_sched_barrier(0)
#define SC_LD1(L, f, OFF, tl) L.f = *(const LAS f32x4*)(vb + (OFF) + (tl) * 256)
#define SC_STEPF(C, L, tl, jprev) do { \
        const f32x2 vv2 = {C.vv, C.vv}; f32x2 p, vk0, vk1, vk2, vk3, t0, t1, t2, t3, q; float pa; \
        p = s0 * (f32x2){C.kA.x, C.kA.y}; SB_; vk0 = vv2 * (f32x2){C.cA.x, C.cA.y}; SB_; qprev += dppf<0xB1>(qprev); SB_; \
        p = __builtin_elementwise_fma(s1, (f32x2){C.kA.z, C.kA.w}, p); SB_; vk1 = vv2 * (f32x2){C.cA.z, C.cA.w}; SB_; qprev += dppf<0x4E>(qprev); SB_; \
        p = __builtin_elementwise_fma(s2, (f32x2){C.kB.x, C.kB.y}, p); SB_; vk2 = vv2 * (f32x2){C.cB.x, C.cB.y}; SB_; qprev += dppf<0x141>(qprev); SB_; \
        p = __builtin_elementwise_fma(s3, (f32x2){C.kB.z, C.kB.w}, p); SB_; vk3 = vv2 * (f32x2){C.cB.z, C.cB.w}; SB_; yk = (cgp == (jprev)) ? qprev : yk; SB_; \
        pa = p.x + p.y; SB_; \
        SC_LD1(L, kA, SB_KK, tl); SB_; SC_LD1(L, kB, SB_KK + 16, tl); SB_; pa += dppf<0xB1>(pa); SB_; \
        SC_LD1(L, wA, SB_W, tl); SB_; SC_LD1(L, wB, SB_W + 16, tl); SB_; pa += dppf<0x4E>(pa); SB_; \
        SC_LD1(L, bA, SB_B, tl); SB_; SC_LD1(L, bB, SB_B + 16, tl); SB_; pa += dppf<0x141>(pa); SB_; \
        { const float sa = -pa; const f32x2 sa2 = {sa, sa}; \
          t0 = __builtin_elementwise_fma(sa2, (f32x2){C.bA.x, C.bA.y}, vk0); SB_; t1 = __builtin_elementwise_fma(sa2, (f32x2){C.bA.z, C.bA.w}, vk1); SB_; \
          t2 = __builtin_elementwise_fma(sa2, (f32x2){C.bB.x, C.bB.y}, vk2); SB_; t3 = __builtin_elementwise_fma(sa2, (f32x2){C.bB.z, C.bB.w}, vk3); SB_; } \
        s0 = __builtin_elementwise_fma(s0, (f32x2){C.wA.x, C.wA.y}, t0); SB_; s1 = __builtin_elementwise_fma(s1, (f32x2){C.wA.z, C.wA.w}, t1); SB_; \
        s2 = __builtin_elementwise_fma(s2, (f32x2){C.wB.x, C.wB.y}, t2); SB_; s3 = __builtin_elementwise_fma(s3, (f32x2){C.wB.z, C.wB.w}, t3); SB_; \
        q = s0 * (f32x2){C.rA.x, C.rA.y}; SB_; SC_LD1(L, cA, SB_K, tl); SB_; \
        q = __builtin_elementwise_fma(s1, (f32x2){C.rA.z, C.rA.w}, q); SB_; SC_LD1(L, cB, SB_K + 16, tl); SB_; \
        q = __builtin_elementwise_fma(s2, (f32x2){C.rB.x, C.rB.y}, q); SB_; SC_LD1(L, rA, SB_R, tl); SB_; \
        q = __builtin_elementwise_fma(s3, (f32x2){C.rB.z, C.rB.w}, q); SB_; SC_LD1(L, rB, SB_R + 16, tl); SB_; L.vv = *(const LAS float*)(vrow + (tl) * 256); SB_; \
        qprev = q.x + q.y; SB_; } while (0)
                StepVec V0, V1, V2; SC_LOADV(V0, 0); SC_LOADV(V1, 1); float yk = 0.f, qprev = 0.f;
#pragma unroll
                for (int t = 0; t < 32; ++t) {
                    switch (t % 3) { case 0: SC_STEPF(V0, V2, (t + 2) & 31, (t + 7) & 7); break; case 1: SC_STEPF(V1, V0, (t + 2) & 31, (t + 7) & 7); break; default: SC_STEPF(V2, V1, (t + 2) & 31, (t + 7) & 7); break; }
                    if ((t & 7) == 0 && t > 0) { *(LAS float*)(lds + SC_Y + (c & 1) * 4096 + ((t - 8) + cgp) * 128 + rl * 4) = yk; }
                    SB_; }
                { const float y31 = sum8(qprev); yk = (cgp == 7) ? y31 : yk; *(LAS float*)(lds + SC_Y + (c & 1) * 4096 + (24 + cgp) * 128 + rl * 4) = yk; }
                __syncthreads();
            }
        }
        __builtin_amdgcn_s_setprio(0);
        if (wave >= 4) { const int pc = SEQ / SC_L - 1, ptid = tid - 256; const size_t growp = (size_t)b * SEQ + pc * SC_L; const int t = ptid >> 3, seg = ptid & 7;
            *(f32x4*)(ys + (growp + t) * 512 + 64 * h + 32 * half + 4 * seg) = *(const LAS f32x4*)(lds + SC_Y + (pc & 1) * 4096 + t * 128 + seg * 16); }
        __syncthreads();
    }
}

#define LERP4(cur, prv, m) (f32x4){ bflo(cur.x) + (bflo(prv.x) - bflo(cur.x)) * m.x, bfhi(cur.x) + (bfhi(prv.x) - bfhi(cur.x)) * m.y, bflo(cur.y) + (bflo(prv.y) - bflo(cur.y)) * m.z, bfhi(cur.y) + (bfhi(prv.y) - bfhi(cur.y)) * m.w }
constexpr int PZ_STAT = 0, PZ_ZT = 1024, PZ_WM = PZ_ZT + 128 * 272, PZ_SG = PZ_WM + 128 * 272;
static_assert(PZ_SG + 128 * 272 <= LDS_BYTES, "post LDS");

__device__ __forceinline__ void post_phase(const Args& a, int li, LAS unsigned char* lds) {
    unsigned char* wsl = a.ws; asm volatile("" : "+s"(wsl));
    int tid_ = threadIdx.x; asm volatile("" : "+v"(tid_)); const int tid = tid_, lane = tid & 63, wave = __builtin_amdgcn_readfirstlane(tid >> 6);
    const bf16* proj = (const bf16*)(wsl + WS_PROJ); const float* ys = (const float*)(wsl + WS_YS); const float* bong = (const float*)(wsl + WS_BON);
    bf16* ycat = (bf16*)(wsl + WS_YCAT);
    const float* mu = a.in[5] + li * P_A; const float* lnx_g = a.in[14] + li * 512; const float* lnx_b = a.in[15] + li * 512;
    const float* bn_g = a.in[16] + li * 512; const float* bn_b = a.in[17] + li * 512; const float* sp_b = a.in[19] + li * 512;
    const bf16* spw = (const bf16*)(wsl + WS_SPW) + (size_t)li * 4 * 128 * 128; const bf16* gupt = (const bf16*)(wsl + WS_GUPT) + (size_t)li * 512 * 128;
    const int n16 = lane & 15, q4 = lane >> 4;
    for (int unit = blockIdx.x; unit < NT / 128; unit += gridDim.x) {
        const size_t t0 = (size_t)unit * 128; const int p0 = (int)(t0 & (SEQ - 1));
        { u32x4 zw[16];
#pragma unroll
          for (int r = 0; r < 16; ++r) zw[r] = *(const u32x4*)(proj + (t0 + wave * 16 + r) * P_EVEN + 2304 + 8 * lane);
#pragma unroll
          for (int r = 0; r < 16; ++r) { const int t = wave * 16 + r; const u32x4 w = zw[r];
            const float x0 = bflo(w.x), x1 = bfhi(w.x), x2 = bflo(w.y), x3 = bfhi(w.y), x4 = bflo(w.z), x5 = bfhi(w.z), x6 = bflo(w.w), x7 = bfhi(w.w);
            float s = ((x0 + x1) + (x2 + x3)) + ((x4 + x5) + (x6 + x7)), qq = ((x0 * x0 + x1 * x1) + (x2 * x2 + x3 * x3)) + ((x4 * x4 + x5 * x5) + (x6 * x6 + x7 * x7));
            s = wave_sum(s); qq = wave_sum(qq); const float mean = s * (1.f / 512.f), var = fmaxf(qq * (1.f / 512.f) - mean * mean, 0.f);
            if (lane == 0) *(LAS f32x2*)(lds + PZ_STAT + t * 8) = (f32x2){mean, 1.0f / sqrtf(var + 1e-5f)}; } }
        { const int t = tid >> 2, seg = tid & 3; const bf16* rp = proj + (t0 + t) * P_EVEN + 1664 + 32 * seg; const bool hasprev = (p0 + t) > 0;
#pragma unroll
          for (int v = 0; v < 4; ++v) { const u32x4 cw = *(const u32x4*)(rp + 8 * v); u32x4 pw = {0u, 0u, 0u, 0u}; if (hasprev) pw = *(const u32x4*)(rp - P_EVEN + 8 * v);
              const f32x4 m0 = *(const f32x4*)(mu + 1664 + 32 * seg + 8 * v), m1 = *(const f32x4*)(mu + 1664 + 32 * seg + 8 * v + 4);
              float x[8] = { bflo(cw.x), bfhi(cw.x), bflo(cw.y), bfhi(cw.y), bflo(cw.z), bfhi(cw.z), bflo(cw.w), bfhi(cw.w) };
              const float p[8] = { bflo(pw.x), bfhi(pw.x), bflo(pw.y), bfhi(pw.y), bflo(pw.z), bfhi(pw.z), bflo(pw.w), bfhi(pw.w) };
              const float mm[8] = { m0.x, m0.y, m0.z, m0.w, m1.x, m1.y, m1.z, m1.w };
#pragma unroll
              for (int e = 0; e < 8; ++e) x[e] = sigmoidf_(x[e] + (p[e] - x[e]) * mm[e]);
              u32x4 o; o.x = pk2(x[0], x[1]); o.y = pk2(x[2], x[3]); o.z = pk2(x[4], x[5]); o.w = pk2(x[6], x[7]);
              *(LAS u32x4*)(lds + PZ_SG + t * 272 + (32 * seg + 8 * v) * 2) = o; } }
        __syncthreads();
        for (int g = 0; g < 4; ++g) {
            { const int cp = tid & 63, tp = tid >> 6; const int c0 = 128 * g + 2 * cp; const float g0 = bn_g[c0], g1 = bn_g[c0 + 1], b0 = bn_b[c0], b1 = bn_b[c0 + 1];
              unsigned wa_[8], wb_[8];
#pragma unroll
              for (int it = 0; it < 8; ++it) { const int tt = tp + 8 * it; wa_[it] = *(const unsigned*)(proj + (t0 + 2 * tt) * P_EVEN + 2304 + c0); wb_[it] = *(const unsigned*)(proj + (t0 + 2 * tt + 1) * P_EVEN + 2304 + c0); }
#pragma unroll
              for (int it = 0; it < 8; ++it) { const int tt = tp + 8 * it; const unsigned wa = wa_[it], wb = wb_[it];
                  const f32x2 sa = *(const LAS f32x2*)(lds + PZ_STAT + (2 * tt) * 8), sb = *(const LAS f32x2*)(lds + PZ_STAT + (2 * tt + 1) * 8);
                  const float za0 = (bflo(wa) - sa.x) * sa.y * g0 + b0, za1 = (bfhi(wa) - sa.x) * sa.y * g1 + b1, zb0 = (bflo(wb) - sb.x) * sb.y * g0 + b0, zb1 = (bfhi(wb) - sb.x) * sb.y * g1 + b1;
                  *(LAS unsigned*)(lds + PZ_ZT + (2 * cp) * 272 + (2 * tt) * 2) = pk2(za0, zb0); *(LAS unsigned*)(lds + PZ_ZT + (2 * cp + 1) * 272 + (2 * tt) * 2) = pk2(za1, zb1); } }
            { const int i = tid >> 2, seg = tid & 3; const bf16* src = spw + (size_t)(g * 128 + i) * 128 + 32 * seg;
#pragma unroll
              for (int v = 0; v < 4; ++v) *(LAS u32x4*)(lds + PZ_WM + i * 272 + (32 * seg + 8 * v) * 2) = *(const u32x4*)(src + 8 * v); }
            __syncthreads();
            { const int db = wave; bf16x8 Af[4];
#pragma unroll
              for (int kk = 0; kk < 4; ++kk) Af[kk] = *(const LAS bf16x8*)(lds + PZ_ZT + (16 * db + n16) * 272 + (32 * kk + 8 * q4) * 2);
              u32x2 uws[8]; float biases[8];
#pragma unroll
              for (int ib = 0; ib < 8; ++ib) { const int i = 16 * ib + n16; uws[ib] = *(const u32x2*)(proj + (t0 + i) * P_EVEN + 1792 + 128 * g + 16 * db + 4 * q4); biases[ib] = sp_b[g * 128 + i]; }
#pragma unroll
              for (int ib = 0; ib < 8; ++ib) { f32x4 acc = {0.f, 0.f, 0.f, 0.f};
#pragma unroll
                  for (int kk = 0; kk < 4; ++kk) if (32 * kk <= 16 * ib + 15) { const bf16x8 Bf = *(const LAS bf16x8*)(lds + PZ_WM + (16 * ib + n16) * 272 + (32 * kk + 8 * q4) * 2);
                      acc = __builtin_amdgcn_mfma_f32_16x16x32_bf16(Af[kk], Bf, acc, 0, 0, 0); }
                  const int i = 16 * ib + n16, c = 128 * g + 16 * db + 4 * q4; const float bias = biases[ib];
                  const u32x2 uw = uws[ib];
                  u32x2 o; o.x = pk2(bflo(uw.x) * (acc[0] + bias), bfhi(uw.x) * (acc[1] + bias)); o.y = pk2(bflo(uw.y) * (acc[2] + bias), bfhi(uw.y) * (acc[3] + bias));
                  *(u32x2*)(ycat + (t0 + i) * DM + 512 + c) = o; } }
            __syncthreads();
        }
        { const int h = wave; bf16x8 Ag[4][4];
#pragma unroll
          for (int cb = 0; cb < 4; ++cb)
#pragma unroll
              for (int kk = 0; kk < 4; ++kk) Ag[cb][kk] = *(const bf16x8*)(gupt + (size_t)(64 * h + 16 * cb + n16) * 128 + 32 * kk + 8 * q4);
          for (int tb = 0; tb < 8; ++tb) {
              f32x4 G[4];
#pragma unroll
              for (int cb = 0; cb < 4; ++cb) G[cb] = (f32x4){0.f, 0.f, 0.f, 0.f};
#pragma unroll
              for (int kk = 0; kk < 4; ++kk) { const bf16x8 Bf = *(const LAS bf16x8*)(lds + PZ_SG + (16 * tb + n16) * 272 + (32 * kk + 8 * q4) * 2);
#pragma unroll
                  for (int cb = 0; cb < 4; ++cb) G[cb] = __builtin_amdgcn_mfma_f32_16x16x32_bf16(Ag[cb][kk], Bf, G[cb], 0, 0, 0); }
              const int tl = 16 * tb + n16; const size_t tt = t0 + tl; const bool hasprev = (p0 + tl) > 0;
              f32x4 y[4]; float s = 0.f;
#pragma unroll
              for (int cb = 0; cb < 4; ++cb) { y[cb] = *(const f32x4*)(ys + tt * 512 + 64 * h + 16 * cb + 4 * q4); s += (y[cb].x + y[cb].y) + (y[cb].z + y[cb].w); }
              s += shx(s, lane, 16); s += shx(s, lane, 32); const float mean = s * (1.f / 64.f); float qq = 0.f;
#pragma unroll
              for (int cb = 0; cb < 4; ++cb) { y[cb] = y[cb] - mean; qq += (y[cb].x * y[cb].x + y[cb].y * y[cb].y) + (y[cb].z * y[cb].z + y[cb].w * y[cb].w); }
              qq += shx(qq, lane, 16); qq += shx(qq, lane, 32); const float rstd = 1.0f / sqrtf(qq * (1.f / 64.f) + 64e-5f);
              const float bon = bong[tt * 8 + h];
#pragma unroll
              for (int cb = 0; cb < 4; ++cb) { const int c = 64 * h + 16 * cb + 4 * q4;
                  const u32x2 cv = *(const u32x2*)(proj + tt * P_EVEN + 1024 + c); u32x2 pv = {0u, 0u}; if (hasprev) pv = *(const u32x2*)(proj + (tt - 1) * P_EVEN + 1024 + c);
                  const f32x4 m = *(const f32x4*)(mu + 1024 + c), lg = *(const f32x4*)(lnx_g + c), lb = *(const f32x4*)(lnx_b + c);
                  const f32x4 v4 = LERP4(cv, pv, m);
                  const f32x4 o = ((y[cb] * rstd) * lg + lb + v4 * bon) * G[cb];
                  u32x2 w; w.x = pk2(o.x, o.y); w.y = pk2(o.z, o.w); *(u32x2*)(ycat + tt * DM + c) = w; }
          } }
        __syncthreads();
    }
}

constexpr int OM_GL = 0, OM_CV = 62 * 1024;
static_assert(OM_CV + 32 * 2048 <= LDS_BYTES, "odd LDS");
template <int WIN> __device__ __forceinline__ void pool_rows(const bf16* proj, bf16* ycat, size_t t0, int p0, int c) {
    float x[47];
#pragma unroll
    for (int i = 0; i < 47; ++i) { const int p = p0 - 15 + i; x[i] = (i >= 16 - WIN) ? ((p >= 0) ? bf1(proj[(t0 - 15 + i) * P_ODD + 1024 + c]) : 0.f) : 0.f; }
#pragma unroll
    for (int t = 0; t < 32; ++t) { float s = 0.f;
#pragma unroll
        for (int k = 0; k < WIN; ++k) s += x[15 + t - k];
        const int p = p0 + t; const float cnt = (float)((p + 1 < WIN) ? p + 1 : WIN);
        ycat[(t0 + t) * DM + 512 + c] = (bf16)f2bf(s / cnt - x[15 + t]); }
}
__device__ __forceinline__ void oddmix_phase(const Args& a, int li, LAS unsigned char* lds) {
    unsigned char* wsl = a.ws; asm volatile("" : "+s"(wsl));
    int tid_ = threadIdx.x; asm volatile("" : "+v"(tid_)); const int tid = tid_, lane = tid & 63, wave = __builtin_amdgcn_readfirstlane(tid >> 6);
    const bf16* proj = (const bf16*)(wsl + WS_PROJ); bf16* ycat = (bf16*)(wsl + WS_YCAT);
    const float* conv_w = a.in[22] + li * 31 * 512; const float* conv_b = a.in[23] + li * 512; const float* cn_g = a.in[24] + li * 512; const float* cn_b = a.in[25] + li * 512;
    float cw[31];
#pragma unroll
    for (int k = 0; k < 31; ++k) cw[k] = conv_w[k * 512 + tid];
    const float cb = conv_b[tid];
    f32x4 g0 = *(const f32x4*)(cn_g + 8 * lane), g1 = *(const f32x4*)(cn_g + 8 * lane + 4), b0 = *(const f32x4*)(cn_b + 8 * lane), b1 = *(const f32x4*)(cn_b + 8 * lane + 4);
    for (int unit = blockIdx.x; unit < NT / 32; unit += gridDim.x) {
        const size_t t0 = (size_t)unit * 32; const int p0 = (int)(t0 & (SEQ - 1));
        { u32x4 gv_[8], gg_[8];
#pragma unroll
          for (int it = 0; it < 8; ++it) { const int task = tid + it * NTHREADS; const int rr = task >> 6, seg = task & 63; const int p = p0 - 30 + rr; gv_[it] = (u32x4){0u, 0u, 0u, 0u}; gg_[it] = (u32x4){0u, 0u, 0u, 0u};
              if (task < 62 * 64 && p >= 0) { const bf16* rp = proj + (t0 + rr - 30) * P_ODD + 8 * seg; gv_[it] = *(const u32x4*)rp; gg_[it] = *(const u32x4*)(rp + 512); } }
#pragma unroll
          for (int it = 0; it < 8; ++it) { const int task = tid + it * NTHREADS; const int rr = task >> 6, seg = task & 63; const u32x4 v = gv_[it], gt = gg_[it]; u32x4 o;
              o.x = pk2(bflo(v.x) * sigmoidf_(bflo(gt.x)), bfhi(v.x) * sigmoidf_(bfhi(gt.x))); o.y = pk2(bflo(v.y) * sigmoidf_(bflo(gt.y)), bfhi(v.y) * sigmoidf_(bfhi(gt.y)));
              o.z = pk2(bflo(v.z) * sigmoidf_(bflo(gt.z)), bfhi(v.z) * sigmoidf_(bfhi(gt.z))); o.w = pk2(bflo(v.w) * sigmoidf_(bflo(gt.w)), bfhi(v.w) * sigmoidf_(bfhi(gt.w)));
              if (task < 62 * 64) *(LAS u32x4*)(lds + OM_GL + rr * 1024 + seg * 16) = o; } }
        __syncthreads();
#pragma unroll 1
        for (int ob = 0; ob < 4; ++ob) { float xin[38];
#pragma unroll
            for (int i = 0; i < 38; ++i) xin[i] = bf1(*(const LAS bf16*)(lds + OM_GL + (ob * 8 + i) * 1024 + tid * 2));
#pragma unroll
            for (int t = 0; t < 8; ++t) { float acc = cb;
#pragma unroll
                for (int k = 0; k < 31; ++k) acc += cw[k] * xin[t + k];
                *(LAS float*)(lds + OM_CV + (ob * 8 + t) * 2048 + tid * 4) = acc; } }
        __syncthreads();
#pragma unroll 1
        for (int r = 0; r < 4; ++r) { const int t = wave * 4 + r; f32x4 v0 = *(const LAS f32x4*)(lds + OM_CV + t * 2048 + lane * 32), v1 = *(const LAS f32x4*)(lds + OM_CV + t * 2048 + lane * 32 + 16);
            float s = ((v0.x + v0.y) + (v0.z + v0.w)) + ((v1.x + v1.y) + (v1.z + v1.w)); s = wave_sum(s); const float mean = s * (1.f / 512.f);
            v0 = v0 - mean; v1 = v1 - mean; float qq = ((v0.x * v0.x + v0.y * v0.y) + (v0.z * v0.z + v0.w * v0.w)) + ((v1.x * v1.x + v1.y * v1.y) + (v1.z * v1.z + v1.w * v1.w));
            qq = wave_sum(qq); const float rstd = 1.0f / sqrtf(qq * (1.f / 512.f) + 1e-5f);
            v0 = v0 * rstd * g0 + b0; v1 = v1 * rstd * g1 + b1;
            u32x4 o; o.x = pk2(v0.x * sigmoidf_(v0.x), v0.y * sigmoidf_(v0.y)); o.y = pk2(v0.z * sigmoidf_(v0.z), v0.w * sigmoidf_(v0.w));
            o.z = pk2(v1.x * sigmoidf_(v1.x), v1.y * sigmoidf_(v1.y)); o.w = pk2(v1.z * sigmoidf_(v1.z), v1.w * sigmoidf_(v1.w));
            *(u32x4*)(ycat + (t0 + t) * DM + 8 * lane) = o; }
        { const int gi = wave >> 1;
          if (gi == 0) pool_rows<2>(proj, ycat, t0, p0, tid); else if (gi == 1) pool_rows<4>(proj, ycat, t0, p0, tid); else if (gi == 2) pool_rows<8>(proj, ycat, t0, p0, tid); else pool_rows<16>(proj, ycat, t0, p0, tid); }
    }
    __syncthreads();
}

#define REPEAT(n) _Pragma("unroll 1") for (int rep_ = 0; rep_ < (n); ++rep_)
#define REP_SYNC 1
#define REP_PREP 1
typedef __attribute__((address_space(1))) unsigned gu32;
#define XB_TMO      128
#define XB_XCNT(j)  (256  + 64 * (j))
#define XB_XSUB(j)  (1280 + 64 * (j))
#define XB_XGEN(j)  (2304 + 64 * (j))
#define XB_TOP      3328
#define XB_TOPGEN   3392
#define XCD_BAR_WORDS 3456
#define XB_SPIN_CAP (1u << 18)

__device__ __forceinline__ unsigned xb_ld(unsigned* p)              { return __hip_atomic_load(p, __ATOMIC_RELAXED, __HIP_MEMORY_SCOPE_AGENT); }
__device__ __forceinline__ unsigned xb_add(unsigned* p, unsigned v) { return __hip_atomic_fetch_add(p, v, __ATOMIC_RELAXED, __HIP_MEMORY_SCOPE_AGENT); }
__device__ __forceinline__ unsigned xb_xcc_id() { return (unsigned)__builtin_amdgcn_s_getreg((3 << 11) | 20) & 0xFu; }
#define XB_SPIN(cond, bar) do { unsigned _sp = 0; while (cond) { __builtin_amdgcn_s_sleep(1); \
    if ((++_sp & 255u) == 0u) { if (xb_ld(&(bar)[XB_TMO])) break; if (_sp > XB_SPIN_CAP) { atomicAdd(&(bar)[XB_TMO], 1u); break; } } } } while (0)

struct XcdBarrier {
    unsigned* bar; unsigned x;
    volatile LAS unsigned* st;
};

__device__ __forceinline__ XcdBarrier xcd_barrier_post(unsigned* bar, volatile LAS unsigned* st) {
    XcdBarrier b; b.bar = bar; b.x = xb_xcc_id(); b.st = st;
    if (threadIdx.x == 0) (void)xb_add(&bar[XB_XCNT(b.x)], 1u);
    return b;
}
__device__ __forceinline__ void xcd_barrier_complete(unsigned* bar, unsigned x, unsigned& nloc, unsigned& nx) {
    const unsigned G = gridDim.x * gridDim.y * gridDim.z;
    unsigned sum, cnt, mine, sp = 0u;
    for (;;) {
        sum = 0u; cnt = 0u; mine = 0u;
#pragma unroll
        for (unsigned j = 0; j < 16; ++j) { const unsigned c = xb_ld(&bar[XB_XCNT(j)]); sum += c; cnt += (c > 0u) ? 1u : 0u; mine = (j == x) ? c : mine; }
        if (sum == G) break;
        __builtin_amdgcn_s_sleep(1);
        if ((++sp & 255u) == 0u) { if (xb_ld(&bar[XB_TMO])) break; if (sp > XB_SPIN_CAP) { atomicAdd(&bar[XB_TMO], 1u); break; } }
    }
    nloc = mine > 0u ? mine : 1u; nx = cnt > 0u ? cnt : 1u;
}

__device__ __forceinline__ void xcd_barrier(const XcdBarrier& b) {
    asm volatile("s_waitcnt vmcnt(0)" ::: "memory");
    __syncthreads();
    if (threadIdx.x == 0) {
        unsigned* bar = b.bar;
        __builtin_amdgcn_s_waitcnt(0);
        unsigned nloc = b.st[0], nx = b.st[1];
        if (nloc == 0u) { xcd_barrier_complete(bar, b.x, nloc, nx); b.st[0] = nloc; b.st[1] = nx; }
        const unsigned old = xb_add(&bar[XB_XSUB(b.x)], 1u);
        const unsigned gen = old / nloc;
        if (old + 1u == (gen + 1u) * nloc) {
            __builtin_amdgcn_fence(__ATOMIC_RELEASE, "agent");
            asm volatile("s_waitcnt vmcnt(0)" ::: "memory");
            const unsigned og = xb_add(&bar[XB_TOP], 1u);
            const unsigned tg = og / nx;
            if (og + 1u == (tg + 1u) * nx) xb_add(&bar[XB_TOPGEN], 1u);
            else XB_SPIN(xb_ld(&bar[XB_TOPGEN]) == tg, bar);
            __builtin_amdgcn_fence(__ATOMIC_ACQUIRE, "agent");
            xb_add(&bar[XB_XGEN(b.x)], 1u);
            asm volatile("s_waitcnt vmcnt(0)" ::: "memory");
        } else {
            XB_SPIN(xb_ld(&bar[XB_XGEN(b.x)]) == gen, bar);
            __builtin_amdgcn_fence(__ATOMIC_ACQUIRE, "agent");
            asm volatile("s_waitcnt vmcnt(0)" ::: "memory");
        }
    }
    __syncthreads();
}

#define GSYNC() do { _Pragma("unroll 1") for (int rs_ = 0; rs_ < REP_SYNC; ++rs_) xcd_barrier(xbar); } while (0)
#define REP_NORM 1
#define REP_G1 1
#define REP_SCAN 1
#define REP_POST 1
#define REP_ODD 1
#define REP_G3 1
__global__ void __launch_bounds__(NTHREADS, 2) trunk_fwd(Args args) {
    extern __shared__ __attribute__((aligned(16))) unsigned char lds_raw[];
    LAS unsigned char* lds = (LAS unsigned char*)lds_raw;
    cg::grid_group grid = cg::this_grid();
    unsigned char* ws = args.ws; const int G = gridDim.x;
    bf16* HN = (bf16*)(ws + WS_HN); bf16* PROJ = (bf16*)(ws + WS_PROJ); bf16* YCAT = (bf16*)(ws + WS_YCAT); bf16* HB = (bf16*)(ws + WS_H);
    if (threadIdx.x < 16) ((LAS unsigned*)(lds + XB_LDS_OFF))[threadIdx.x] = 0u;
    __syncthreads();
    const XcdBarrier xbar = xcd_barrier_post((unsigned*)(ws + WS_CTL), (volatile LAS unsigned*)(lds + XB_LDS_OFF));
    REPEAT(REP_PREP) { prep_phase(args, lds); }
    rmsnorm_phase(args.in[0], nullptr, args.in[1], HN, HB);
    if (args.out == nullptr) grid.sync();
    GSYNC();
#pragma unroll 1
    for (int layer = 0; layer < DEPTH; ++layer) {
        const int li = layer >> 1; const bool even = (layer & 1) == 0;
        const float* hin = (layer == 0) ? args.in[0] : nullptr;
        asm volatile("" : "+s"(HN), "+s"(PROJ), "+s"(YCAT), "+s"(ws), "+s"(hin), "+s"(HB));
        if (even) {
            REPEAT(REP_G1) { pg8::Gemm g{HN, (const bf16*)(ws + WS_EVIN) + (size_t)li * P_EVEN * DM, NT, P_EVEN, DM}; pg8::StaticOrder S; S.init(NT, P_EVEN, G, (int)blockIdx.x);
              pg8::EpiProj E{PROJ, P_EVEN, 7}; pg8::gemm_phase<pg8::EpiProj, pg8::StaticOrder, true, true>(lds, g, S, E);
            GSYNC(); }
            REPEAT(REP_SCAN) { scan_phase(args, li, lds);
            GSYNC(); }
            REPEAT(REP_POST) { post_phase(args, li, lds);
            GSYNC(); }
        } else {
            REPEAT(REP_G1) { pg8::Gemm g{HN, (const bf16*)(ws + WS_ODIN) + (size_t)li * P_ODD * DM, NT, P_ODD, DM}; pg8::StaticOrder S; S.init(NT, P_ODD, G, (int)blockIdx.x);
              pg8::EpiProj E{PROJ, P_ODD, 1000}; pg8::gemm_phase<pg8::EpiProj, pg8::StaticOrder, true, true>(lds, g, S, E);
            GSYNC(); }
            REPEAT(REP_ODD) { oddmix_phase(args, li, lds);
            GSYNC(); }
        }
        { pg8::Gemm g{YCAT, (const bf16*)(ws + WS_WOUT) + (size_t)layer * DM * DM, NT, DM, DM}; pg8::StaticOrder S; S.init(NT, DM, G, (int)blockIdx.x);
          unsigned* xb = (unsigned*)(ws + WS_XB); unsigned* pc = (unsigned*)(ws + WS_CNT); const float* gn = args.in[2] + layer * DM; const unsigned tg = 16u * (unsigned)(2 * layer + 1);
          { pg8::EpiResX<false, false> E{nullptr, HB, HB, HN, nullptr, gn, DM, xb, pc, tg, lds}; pg8::gemm_phase<pg8::EpiResX<false, false>, pg8::StaticOrder, true, true>(lds, g, S, E); } }
        GSYNC();
        REPEAT(REP_G3) { pg8::Gemm g{HN, (const bf16*)(ws + WS_GU) + (size_t)layer * 2 * FF * DM, NT, 2 * FF, DM}; pg8::StaticOrder S; S.init(NT, 2 * FF, G, (int)blockIdx.x);
          pg8::EpiSwiGLU E{PROJ, FF}; pg8::gemm_phase<pg8::EpiSwiGLU, pg8::StaticOrder, true, true>(lds, g, S, E);
        GSYNC(); }
        { pg8::Gemm g{PROJ, (const bf16*)(ws + WS_DN) + (size_t)layer * DM * FF, NT, DM, FF}; pg8::StaticOrder S; S.init(NT, DM, G, (int)blockIdx.x);
          unsigned* xb = (unsigned*)(ws + WS_XB); unsigned* pc = (unsigned*)(ws + WS_CNT); const unsigned tg = 16u * (unsigned)(2 * layer + 2);
          if (layer == DEPTH - 1) { pg8::EpiResX<false, true> E{nullptr, HB, nullptr, nullptr, args.out, args.in[3], DM, xb, pc, tg, lds}; pg8::gemm_phase<pg8::EpiResX<false, true>, pg8::StaticOrder, true, true>(lds, g, S, E); }
          else { pg8::EpiResX<false, false> E{nullptr, HB, HB, HN, nullptr, args.in[1] + (layer + 1) * DM, DM, xb, pc, tg, lds}; pg8::gemm_phase<pg8::EpiResX<false, false>, pg8::StaticOrder, true, true>(lds, g, S, E); } }
        GSYNC();
    }
}

extern "C" void kernel_launch(void* const* d_in, const int* in_sizes, int n_in, void* d_out, int out_size, void* d_ws, size_t ws_size, hipStream_t stream) {
    static int grid = 0;
    if (grid == 0) {
        if (n_in != 32 || out_size != NT * DM || ws_size < WS_END) { fprintf(stderr, "kernel_launch: unexpected shapes (n_in %d out %d ws %zu)\n", n_in, out_size, ws_size); grid = -1; return; }
        int dev = 0, cus = 0, per_cu = 0;
        hipGetDevice(&dev); hipDeviceGetAttribute(&cus, hipDeviceAttributeMultiprocessorCount, dev);
        if (hipFuncSetAttribute((const void*)trunk_fwd, hipFuncAttributeMaxDynamicSharedMemorySize, LDS_BYTES) != hipSuccess) { fprintf(stderr, "kernel_launch: hipFuncSetAttribute failed\n"); grid = -1; return; }
        if (hipOccupancyMaxActiveBlocksPerMultiprocessor(&per_cu, (const void*)trunk_fwd, NTHREADS, LDS_BYTES) != hipSuccess || per_cu < 1) { fprintf(stderr, "kernel_launch: occupancy query says %d\n", per_cu); per_cu = 1; }
        (void)hipGetLastError();
        grid = cus * 1;
    }
    if (grid < 0) return;
    if (hipMemsetAsync((char*)d_ws + WS_CTL, 0, 131072, stream) != hipSuccess) { fprintf(stderr, "kernel_launch: memset of the control words failed\n"); return; }
    Args a{};
    for (int i = 0; i < 32; ++i) a.in[i] = (const float*)d_in[i];
    a.out = (float*)d_out; a.ws = (unsigned char*)d_ws;
    void* kargs[] = { &a };
    hipError_t e = hipLaunchCooperativeKernel((const void*)trunk_fwd, dim3(grid), dim3(NTHREADS), kargs, LDS_BYTES, stream);
    if (e != hipSuccess) fprintf(stderr, "cooperative launch failed: %s (grid %d)\n", hipGetErrorString(e), grid);
}
```

```cpp
#include <hip/hip_runtime.h>
#include <hip/hip_cooperative_groups.h>
#include <cstdio>
#include <cstdint>
namespace pg8 {
#define PG8_LAS __attribute__((address_space(3)))
typedef unsigned short bf16_t;
typedef short bf16x8 __attribute__((ext_vector_type(8)));
typedef float f32x4 __attribute__((ext_vector_type(4)));
typedef unsigned u32x4 __attribute__((ext_vector_type(4)));
constexpr int BM = 256, BK = 64, HALF = 128, HTB = HALF * BK * 2  , STAGE_BYTES = 8 * HTB, NXCD = 8, WGM = 8;

__host__ __device__ __forceinline__ int lds_byte(int r, int c) { const int st = (r >> 4) * 2 + (c >> 5), rr = r & 15, cc = c & 31, ob = rr * 64 + cc * 2; return st * 1024 + (ob ^ (((ob >> 9) & 1) << 5)); }
__host__ __device__ __forceinline__ void stage_rc(int b, int& R, int& C) { const int st = b / 1024, sb = b % 1024, swz = sb ^ (((sb >> 9) & 1) << 5); R = (st >> 1) * 16 + swz / 64; C = (st & 1) * 32 + (swz % 64) / 2; }
__host__ __device__ __forceinline__ int perm32(int rho) { const int n = rho >> 4, i = rho & 15; return 8 * (i >> 2) + 4 * n + (i & 3); }

struct Unit { int pm, pn; };
struct Gemm { const bf16_t* A; const bf16_t* Bt; int M, N, K; };

struct StaticOrder {
    int nM, nN, nwg, G, c;
    __host__ __device__ void init(int M, int N, int G_, int c_) { nM = M / BM; nN = N / BM; nwg = nM * nN; G = G_; c = c_; }
    __host__ __device__ bool next(int i, Unit& u) const {
        const long L = (long)i * G + c; if (L >= nwg) return false;
        int wgid = (int)L; { const int q = nwg / NXCD, r = nwg % NXCD, xcd = wgid % NXCD, off = wgid / NXCD; wgid = (xcd < r ? xcd * (q + 1) : r * (q + 1) + (xcd - r) * q) + off; }
        const int nig = WGM * nN, gid = wgid / nig, fm = gid * WGM, gsz = (nM - fm) < WGM ? (nM - fm) : WGM;
        u.pm = fm + ((wgid % nig) % gsz); u.pn = (wgid % nig) / gsz; return true;
    }
    __device__ __forceinline__ void a_ready(const Unit&) const {}
    __device__ __forceinline__ void done(const Unit&) const {}
};

__device__ __forceinline__ unsigned cvt_pk_bf16(float lo, float hi) { unsigned r; asm volatile("v_cvt_pk_bf16_f32 %0, %1, %2" : "=v"(r) : "v"(lo), "v"(hi)); return r; }
typedef float f32x2 __attribute__((ext_vector_type(2)));
__device__ __forceinline__ f32x2 gelu_pk(f32x2 v) {
    const f32x2 av = __builtin_elementwise_abs(v), d = av * 0.2316418882f + 1.0f;
    f32x2 t; t.x = __builtin_amdgcn_rcpf(d.x); t.y = __builtin_amdgcn_rcpf(d.y);
    f32x2 q = t * 0.5307027145f + (-0.7265760135f); q = q * t + 0.7107068705f; q = q * t + (-0.142248368f); q = q * t + 0.127414796f; q = q * t;
    const f32x2 s = (v * v) * (-0.72134752044f);
    f32x2 e; e.x = __builtin_amdgcn_exp2f(s.x); e.y = __builtin_amdgcn_exp2f(s.y);
    const f32x2 m = v * (q * e), r = v - m;
    f32x2 o; o.x = v.x < 0.f ? m.x : r.x; o.y = v.y < 0.f ? m.y : r.y; return o;
}

struct EpiProj {
    static constexpr bool PERM = true, AFTER_DRAIN = false;
    bf16_t* O; int ldc; int gelu_from;
    __device__ __forceinline__ void operator()(const f32x4 (&acc)[2][2][4][2], const Unit& u, int wr, int wc, int fr, int fq) const {
        const int row0 = u.pm * BM + wr * 64 + fr; const int col0 = u.pn * BM + wc * 32 + 8 * fq; const bool act = u.pn >= gelu_from;
#pragma unroll
        for (int ai = 0; ai < 2; ++ai)
#pragma unroll
            for (int m = 0; m < 4; ++m) { bf16_t* rowp = O + (size_t)(row0 + ai * HALF + m * 16) * ldc + col0;
#pragma unroll
                for (int bj = 0; bj < 2; ++bj) { f32x4 v0 = acc[ai][bj][m][0], v1 = acc[ai][bj][m][1];
                    if (act) { f32x2 a = gelu_pk((f32x2){v0[0], v0[1]}), b = gelu_pk((f32x2){v0[2], v0[3]}), c = gelu_pk((f32x2){v1[0], v1[1]}), d = gelu_pk((f32x2){v1[2], v1[3]});
                        v0 = (f32x4){a.x, a.y, b.x, b.y}; v1 = (f32x4){c.x, c.y, d.x, d.y}; }
                    u32x4 w; w.x = cvt_pk_bf16(v0[0], v0[1]); w.y = cvt_pk_bf16(v0[2], v0[3]); w.z = cvt_pk_bf16(v1[0], v1[1]); w.w = cvt_pk_bf16(v1[2], v1[3]);
                    *(u32x4*)(rowp + bj * HALF) = w; } }
    }
};
template <bool BASE_F32> struct EpiResT {
    static constexpr bool PERM = true, AFTER_DRAIN = false;
    const float* basef; const bf16_t* baseh; bf16_t* hout; int ldc; float* ssp;
    __device__ __forceinline__ void operator()(const f32x4 (&acc)[2][2][4][2], const Unit& u, int wr, int wc, int fr, int fq) const {
        const int lane = fq * 16 + fr; const int row0 = u.pm * BM + wr * 64 + fr, col0 = u.pn * BM + wc * 32 + 8 * fq;
#pragma unroll
        for (int ai = 0; ai < 2; ++ai)
#pragma unroll
            for (int mp = 0; mp < 2; ++mp) {
                if constexpr (BASE_F32) {
                    f32x4 bs[2][2][2];
#pragma unroll
                    for (int mm = 0; mm < 2; ++mm)
#pragma unroll
                        for (int bj = 0; bj < 2; ++bj)
#pragma unroll
                            for (int n = 0; n < 2; ++n) bs[mm][bj][n] = *(const f32x4*)(basef + (size_t)(row0 + ai * HALF + (2 * mp + mm) * 16) * ldc + col0 + bj * HALF + n * 4);
#pragma unroll
                    for (int mm = 0; mm < 2; ++mm)
#pragma unroll
                        for (int bj = 0; bj < 2; ++bj) { const int m = 2 * mp + mm; const f32x4 h0 = bs[mm][bj][0] + acc[ai][bj][m][0], h1 = bs[mm][bj][1] + acc[ai][bj][m][1];
                            u32x4 w; w.x = cvt_pk_bf16(h0[0], h0[1]); w.y = cvt_pk_bf16(h0[2], h0[3]); w.z = cvt_pk_bf16(h1[0], h1[1]); w.w = cvt_pk_bf16(h1[2], h1[3]);
                            *(u32x4*)(hout + (size_t)(row0 + ai * HALF + m * 16) * ldc + col0 + bj * HALF) = w; }
                } else {
                    u32x4 bs[2][2];
#pragma unroll
                    for (int mm = 0; mm < 2; ++mm)
#pragma unroll
                        for (int bj = 0; bj < 2; ++bj) bs[mm][bj] = *(const u32x4*)(baseh + (size_t)(row0 + ai * HALF + (2 * mp + mm) * 16) * ldc + col0 + bj * HALF);
#pragma unroll
                    for (int mm = 0; mm < 2; ++mm) { const int m = 2 * mp + mm; float ss = 0.f;
#pragma unroll
                        for (int bj = 0; bj < 2; ++bj) { const u32x4 q = bs[mm][bj]; const f32x4 a0 = acc[ai][bj][m][0], a1 = acc[ai][bj][m][1];
                            const f32x4 h0 = {__builtin_bit_cast(float, q.x << 16) + a0[0], __builtin_bit_cast(float, q.x & 0xffff0000u) + a0[1], __builtin_bit_cast(float, q.y << 16) + a0[2], __builtin_bit_cast(float, q.y & 0xffff0000u) + a0[3]};
                            const f32x4 h1 = {__builtin_bit_cast(float, q.z << 16) + a1[0], __builtin_bit_cast(float, q.z & 0xffff0000u) + a1[1], __builtin_bit_cast(float, q.w << 16) + a1[2], __builtin_bit_cast(float, q.w & 0xffff0000u) + a1[3]};
                            u32x4 w; w.x = cvt_pk_bf16(h0[0], h0[1]); w.y = cvt_pk_bf16(h0[2], h0[3]); w.z = cvt_pk_bf16(h1[0], h1[1]); w.w = cvt_pk_bf16(h1[2], h1[3]);
                            *(u32x4*)(hout + (size_t)(row0 + ai * HALF + m * 16) * ldc + col0 + bj * HALF) = w;
                            ss += ((h0[0] * h0[0] + h0[1] * h0[1]) + (h0[2] * h0[2] + h0[3] * h0[3])) + ((h1[0] * h1[0] + h1[1] * h1[1]) + (h1[2] * h1[2] + h1[3] * h1[3])); }
                        if (ssp) { ss += __builtin_bit_cast(float, __builtin_amdgcn_ds_bpermute((lane ^ 16) << 2, __builtin_bit_cast(int, ss)));
                            ss += __builtin_bit_cast(float, __builtin_amdgcn_ds_bpermute((lane ^ 32) << 2, __builtin_bit_cast(int, ss)));
                            if (fq == 0) ssp[(size_t)(row0 + ai * HALF + m * 16) * 16 + u.pn * 4 + wc] = ss; } }
                }
                asm volatile("" ::: "memory"); }
    }
};
template <bool BASE_F32, bool FINAL> struct EpiResX {
    static constexpr bool PERM = true, AFTER_DRAIN = false;
    const float* basef; const bf16_t* baseh; bf16_t* hout; bf16_t* hn; float* outf; const float* gain; int ldc;
    unsigned* xbuf; unsigned* cnt; unsigned target; PG8_LAS unsigned char* lds;
    __device__ __forceinline__ void operator()(f32x4 (&acc)[2][2][4][2], const Unit& u, int wr, int wc, int fr_, int fq_) const {
        int fr = fr_, fq = fq_; asm volatile("" : "+v"(fr), "+v"(fq));
        const int lane = fq * 16 + fr, wid = wr * 4 + wc, tid = wid * 64 + lane;
        PG8_LAS float* P = (PG8_LAS float*)(lds + 131072); PG8_LAS float* S = (PG8_LAS float*)(lds + 131072 + 4096);
        const int row0 = u.pm * BM + wr * 64 + fr, col0 = u.pn * BM + wc * 32 + 8 * fq;
        if constexpr (BASE_F32) {
#pragma unroll
            for (int ai = 0; ai < 2; ++ai)
#pragma unroll
                for (int mp = 0; mp < 2; ++mp) { f32x4 bsf[2][2][2];
#pragma unroll
                    for (int mm = 0; mm < 2; ++mm)
#pragma unroll
                        for (int bj = 0; bj < 2; ++bj) { const size_t off = (size_t)(row0 + ai * HALF + (2 * mp + mm) * 16) * ldc + col0 + bj * HALF; bsf[mm][bj][0] = *(const f32x4*)(basef + off); bsf[mm][bj][1] = *(const f32x4*)(basef + off + 4); }
#pragma unroll
                    for (int mm = 0; mm < 2; ++mm)
#pragma unroll
                        for (int bj = 0; bj < 2; ++bj) { const int m = 2 * mp + mm; acc[ai][bj][m][0] += bsf[mm][bj][0]; acc[ai][bj][m][1] += bsf[mm][bj][1]; }
                    asm volatile("" ::: "memory"); }
        } else {
#pragma unroll
            for (int ai = 0; ai < 2; ++ai) { u32x4 bsh[4][2];
#pragma unroll
                for (int m = 0; m < 4; ++m)
#pragma unroll
                    for (int bj = 0; bj < 2; ++bj) bsh[m][bj] = *(const u32x4*)(baseh + (size_t)(row0 + ai * HALF + m * 16) * ldc + col0 + bj * HALF);
#pragma unroll
                for (int m = 0; m < 4; ++m)
#pragma unroll
                    for (int bj = 0; bj < 2; ++bj) { const u32x4 q = bsh[m][bj];
                        acc[ai][bj][m][0] += (f32x4){__builtin_bit_cast(float, q.x << 16), __builtin_bit_cast(float, q.x & 0xffff0000u), __builtin_bit_cast(float, q.y << 16), __builtin_bit_cast(float, q.y & 0xffff0000u)};
                        acc[ai][bj][m][1] += (f32x4){__builtin_bit_cast(float, q.z << 16), __builtin_bit_cast(float, q.z & 0xffff0000u), __builtin_bit_cast(float, q.w << 16), __builtin_bit_cast(float, q.w & 0xffff0000u)}; }
                asm volatile("" ::: "memory"); }
        }
#pragma unroll
        for (int ai = 0; ai < 2; ++ai)
#pragma unroll
            for (int m = 0; m < 4; ++m) { float ss = 0.f;
#pragma unroll
                for (int bj = 0; bj < 2; ++bj) { const f32x4 h0 = acc[ai][bj][m][0], h1 = acc[ai][bj][m][1];
                    ss += ((h0[0] * h0[0] + h0[1] * h0[1]) + (h0[2] * h0[2] + h0[3] * h0[3])) + ((h1[0] * h1[0] + h1[1] * h1[1]) + (h1[2] * h1[2] + h1[3] * h1[3])); }
                ss += __builtin_bit_cast(float, __builtin_amdgcn_ds_bpermute((lane ^ 16) << 2, __builtin_bit_cast(int, ss)));
                ss += __builtin_bit_cast(float, __builtin_amdgcn_ds_bpermute((lane ^ 32) << 2, __builtin_bit_cast(int, ss)));
                if (fq == 0) P[(ai * HALF + wr * 64 + m * 16 + fr) * 4 + wc] = ss; }
        asm volatile("s_waitcnt lgkmcnt(0)" ::: "memory"); __builtin_amdgcn_s_barrier(); asm volatile("" ::: "memory");
        if (wid < 4) {
            const f32x4 p = *(const PG8_LAS f32x4*)(P + tid * 4); const float bs = (p[0] + p[1]) + (p[2] + p[3]);
            __hip_atomic_store(xbuf + ((size_t)(u.pm * BM + tid) * 4 + u.pn), __builtin_bit_cast(unsigned, bs), __ATOMIC_RELAXED, __HIP_MEMORY_SCOPE_AGENT);
            asm volatile("s_waitcnt vmcnt(0)" ::: "memory");
            if (lane == 0) __hip_atomic_fetch_add(cnt + 64 * u.pm, 1u, __ATOMIC_RELAXED, __HIP_MEMORY_SCOPE_AGENT);
        }
        if (wid == 0) {
            unsigned spins = 0;
            while ((unsigned)__builtin_amdgcn_readfirstlane((int)__hip_atomic_load(cnt + 64 * u.pm, __ATOMIC_RELAXED, __HIP_MEMORY_SCOPE_AGENT)) < target) { __builtin_amdgcn_s_sleep(1); if (++spins > (1u << 21)) break; }
        }
        asm volatile("s_waitcnt vmcnt(0) lgkmcnt(0)" ::: "memory"); __builtin_amdgcn_s_barrier(); asm volatile("" ::: "memory");
        if (wid < 4) {
            const unsigned* slot = xbuf + (size_t)(u.pm * BM + tid) * 4; float s = 0.f;
#pragma unroll
            for (int q = 0; q < 4; ++q) s += __builtin_bit_cast(float, __hip_atomic_load(slot + q, __ATOMIC_RELAXED, __HIP_MEMORY_SCOPE_AGENT));
            S[tid] = __builtin_amdgcn_rsqf(s * (1.0f / 1024.0f) + 1e-5f);
        }
        asm volatile("s_waitcnt vmcnt(0) lgkmcnt(0)" ::: "memory"); __builtin_amdgcn_s_barrier(); asm volatile("" ::: "memory");
        asm volatile("" : "+v"(fr), "+v"(fq));
        const int row0b = u.pm * BM + wr * 64 + fr, col0b = u.pn * BM + wc * 32 + 8 * fq;
        f32x4 gv[2][2];
#pragma unroll
        for (int bj = 0; bj < 2; ++bj) { gv[bj][0] = *(const f32x4*)(gain + col0b + bj * HALF); gv[bj][1] = *(const f32x4*)(gain + col0b + bj * HALF + 4); }
#pragma unroll
        for (int ai = 0; ai < 2; ++ai)
#pragma unroll
            for (int m = 0; m < 4; ++m) { const float r = S[ai * HALF + wr * 64 + m * 16 + fr]; const size_t off = (size_t)(row0b + ai * HALF + m * 16) * ldc + col0b;
#pragma unroll
                for (int bj = 0; bj < 2; ++bj) { const f32x4 h0 = acc[ai][bj][m][0], h1 = acc[ai][bj][m][1]; const f32x4 v0 = h0 * r * gv[bj][0], v1 = h1 * r * gv[bj][1];
                    if constexpr (!FINAL) { u32x4 w; w.x = cvt_pk_bf16(h0[0], h0[1]); w.y = cvt_pk_bf16(h0[2], h0[3]); w.z = cvt_pk_bf16(h1[0], h1[1]); w.w = cvt_pk_bf16(h1[2], h1[3]); *(u32x4*)(hout + off + bj * HALF) = w; }
                    if constexpr (FINAL) { *(f32x4*)(outf + off + bj * HALF) = v0; *(f32x4*)(outf + off + bj * HALF + 4) = v1; }
                    else { u32x4 w; w.x = cvt_pk_bf16(v0[0], v0[1]); w.y = cvt_pk_bf16(v0[2], v0[3]); w.z = cvt_pk_bf16(v1[0], v1[1]); w.w = cvt_pk_bf16(v1[2], v1[3]);
                        *(u32x4*)(hn + off + bj * HALF) = w; } } }
    }
};
struct EpiSwiGLU {
    static constexpr bool PERM = true, AFTER_DRAIN = false;
    bf16_t* O; int ldc;
    __device__ __forceinline__ void operator()(const f32x4 (&acc)[2][2][4][2], const Unit& u, int wr, int wc, int fr, int fq) const {
        const int row0 = u.pm * BM + wr * 64 + fr; const int col0 = u.pn * HALF + wc * 32 + 8 * fq;
#pragma unroll
        for (int ai = 0; ai < 2; ++ai)
#pragma unroll
            for (int m = 0; m < 4; ++m) { bf16_t* rowp = O + (size_t)(row0 + ai * HALF + m * 16) * ldc + col0;
                float o[8];
#pragma unroll
                for (int n = 0; n < 2; ++n)
#pragma unroll
                    for (int j = 0; j < 4; ++j) { const float g = acc[ai][0][m][n][j], up = acc[ai][1][m][n][j];
                        o[n * 4 + j] = g * __builtin_amdgcn_rcpf(1.0f + __builtin_amdgcn_exp2f(-1.44269504f * g)) * up; }
                u32x4 w; w.x = cvt_pk_bf16(o[0], o[1]); w.y = cvt_pk_bf16(o[2], o[3]); w.z = cvt_pk_bf16(o[4], o[5]); w.w = cvt_pk_bf16(o[6], o[7]);
                *(u32x4*)rowp = w; }
    }
};
template <class Epi, class Sched, bool ALIGN_EPI = false, bool SP2 = false>
__device__ __forceinline__ void gemm_phase(PG8_LAS unsigned char* lds, const Gemm g, const Sched& S, const Epi& E) {
    int tid_ = threadIdx.x; asm volatile("" : "+v"(tid_)); const int tid = tid_, wid = __builtin_amdgcn_readfirstlane(tid >> 6), lane = tid & 63, wr = wid >> 2, wc = wid & 3, fr = lane & 15, fq = lane >> 4;
    const int K = g.K, nt = K / BK;
    unsigned voffA[2], voffB[2];
#pragma unroll
    for (int i = 0; i < 2; ++i) { int R, C; stage_rc(tid * 16 + i * 8192, R, C); const int Rb = Epi::PERM ? ((R & ~31) + perm32(R & 31)) : R;
        voffA[i] = (unsigned)(R * K + C) * 2u; voffB[i] = (unsigned)(Rb * K + C) * 2u; }
    const size_t kstep = (size_t)(BK * 2);
    const size_t hstep = (size_t)HALF * K * 2;
    const size_t tstep = 2 * hstep;
    const unsigned ldsw = (unsigned)wid * 1024u;
    const int aoff = lds_byte(wr * 64 + fr, fq * 8), boff = lds_byte(wc * 32 + fr, fq * 8);
#define PG8_SA(b, h) (((b) * 2 + (h)) * HTB)
#define PG8_SB(b, h) ((4 + (b) * 2 + (h)) * HTB)
#define PG8_STAGE(bufoff, gbase, voff) do { _Pragma("unroll") for (int _i = 0; _i < 2; ++_i) \
        __builtin_amdgcn_global_load_lds((const unsigned*)((const char*)(gbase) + (voff)[_i]), (PG8_LAS unsigned*)(lds + (bufoff) + ldsw + _i * 8192), 16, 0, 0); } while (0)
#define PG8_LDA(dst, b, h) do { _Pragma("unroll") for (int m = 0; m < 4; ++m) _Pragma("unroll") for (int k = 0; k < 2; ++k) dst[m][k] = *(const PG8_LAS bf16x8*)(lds + PG8_SA(b, h) + aoff + m * 2048 + k * 1024); } while (0)
#define PG8_LDB(dst, b, h) do { _Pragma("unroll") for (int n = 0; n < 2; ++n) _Pragma("unroll") for (int k = 0; k < 2; ++k) dst[n][k] = *(const PG8_LAS bf16x8*)(lds + PG8_SB(b, h) + boff + n * 2048 + k * 1024); } while (0)
#define PG8_MMA(ai, bj, At, Bt) do { __builtin_amdgcn_s_setprio(1); _Pragma("unroll") for (int m = 0; m < 4; ++m) _Pragma("unroll") for (int n = 0; n < 2; ++n) _Pragma("unroll") for (int k = 0; k < 2; ++k) \
        acc[ai][bj][m][n] = __builtin_amdgcn_mfma_f32_16x16x32_bf16(Bt[n][k], At[m][k], acc[ai][bj][m][n], 0, 0, 0); __builtin_amdgcn_s_setprio(0); } while (0)
#define PG8_WAIT_V(n) asm volatile("s_waitcnt vmcnt(" #n ")" ::: "memory")
#define PG8_WAIT_L(n) asm volatile("s_waitcnt lgkmcnt(" #n ")" ::: "memory")
#define PG8_BAR __builtin_amdgcn_s_barrier()
#define PG8_SCHED __builtin_amdgcn_sched_barrier(0)
    Unit cur, nxt; int ui = 0;
    if (!S.next(0, cur)) return;
    f32x4 acc[2][2][4][2];
#pragma unroll
    for (int a = 0; a < 2; ++a)
#pragma unroll
        for (int b = 0; b < 2; ++b)
#pragma unroll
            for (int m = 0; m < 4; ++m)
#pragma unroll
                for (int n = 0; n < 2; ++n) acc[a][b][m][n] = (f32x4){0.f, 0.f, 0.f, 0.f};
    bf16x8 At[4][2], B0[2][2], B1[2][2];
    const char* cA = (const char*)g.A + (size_t)cur.pm * tstep; const char* cB = (const char*)g.Bt + (size_t)cur.pn * tstep;
    S.a_ready(cur);
    if constexpr (SP2) {
        PG8_STAGE(PG8_SB(0, 0), cB, voffB); PG8_STAGE(PG8_SB(0, 1), cB + hstep, voffB); PG8_STAGE(PG8_SA(0, 0), cA, voffA); PG8_STAGE(PG8_SA(0, 1), cA + hstep, voffA);
        if (wr == 1) PG8_BAR;
        PG8_WAIT_V(2); PG8_BAR;
        PG8_STAGE(PG8_SB(1, 0), cB + kstep, voffB); PG8_STAGE(PG8_SA(1, 0), cA + kstep, voffA); PG8_STAGE(PG8_SB(1, 1), cB + hstep + kstep, voffB);
        PG8_WAIT_V(6); PG8_BAR;
    } else {
        PG8_STAGE(PG8_SB(0, 0), cB, voffB); PG8_STAGE(PG8_SA(0, 0), cA, voffA); PG8_STAGE(PG8_SB(0, 1), cB + hstep, voffB); PG8_STAGE(PG8_SA(0, 1), cA + hstep, voffA);
        if (wr == 1) PG8_BAR;
        PG8_WAIT_V(4); PG8_BAR;
        PG8_STAGE(PG8_SB(1, 0), cB + kstep, voffB); PG8_STAGE(PG8_SA(1, 0), cA + kstep, voffA); PG8_STAGE(PG8_SB(1, 1), cB + hstep + kstep, voffB);
        PG8_WAIT_V(6); PG8_BAR;
    }
    for (;;) {
        const bool has_next = S.next(ui + 1, nxt);
        const char* nA = has_next ? (const char*)g.A + (size_t)nxt.pm * tstep : cA; const char* nB = has_next ? (const char*)g.Bt + (size_t)nxt.pn * tstep : cB;
        for (int t = 0; t < nt; t += 2) {
            const bool last = (t == nt - 2);
            const char* a1 = cA + (size_t)(t + 1) * kstep;
            const char* a2 = last ? nA : cA + (size_t)(t + 2) * kstep; const char* b2 = last ? nB : cB + (size_t)(t + 2) * kstep;
            const char* a3 = a2 + kstep; const char* b3 = b2 + kstep;
            if (last && has_next) S.a_ready(nxt);
            if constexpr (SP2) {
            PG8_LDB(B0, 0, 0); PG8_LDB(B1, 0, 1); PG8_SCHED; PG8_LDA(At, 0, 0); PG8_STAGE(PG8_SA(1, 1), a1 + hstep, voffA);
            PG8_WAIT_V(8); PG8_WAIT_L(0); PG8_BAR; PG8_MMA(0, 0, At, B0); PG8_MMA(0, 1, At, B1); PG8_BAR; PG8_SCHED;
            PG8_LDA(At, 0, 1); PG8_STAGE(PG8_SB(0, 0), b2, voffB); PG8_STAGE(PG8_SB(0, 1), b2 + hstep, voffB); PG8_STAGE(PG8_SA(0, 0), a2, voffA);
            PG8_WAIT_V(8); PG8_WAIT_L(0); PG8_BAR; PG8_MMA(1, 0, At, B0); PG8_MMA(1, 1, At, B1); PG8_BAR; PG8_SCHED;
            PG8_LDB(B0, 1, 0); PG8_LDB(B1, 1, 1); PG8_SCHED; PG8_LDA(At, 1, 0); PG8_STAGE(PG8_SA(0, 1), a2 + hstep, voffA);
            PG8_WAIT_V(8); PG8_WAIT_L(0); PG8_BAR; PG8_MMA(0, 0, At, B0); PG8_MMA(0, 1, At, B1); PG8_BAR; PG8_SCHED;
            PG8_LDA(At, 1, 1); PG8_STAGE(PG8_SB(1, 0), b3, voffB); PG8_STAGE(PG8_SB(1, 1), b3 + hstep, voffB); PG8_STAGE(PG8_SA(1, 0), a3, voffA);
            PG8_WAIT_V(8); PG8_WAIT_L(0); PG8_BAR; PG8_MMA(1, 0, At, B0); PG8_MMA(1, 1, At, B1); PG8_BAR; PG8_SCHED;
            } else {
            PG8_LDB(B0, 0, 0); PG8_SCHED; PG8_LDA(At, 0, 0); PG8_STAGE(PG8_SA(1, 1), a1 + hstep, voffA);
            PG8_WAIT_L(8); PG8_BAR; PG8_WAIT_L(0); PG8_MMA(0, 0, At, B0); PG8_BAR; PG8_SCHED;
            PG8_LDB(B1, 0, 1); PG8_STAGE(PG8_SB(0, 0), b2, voffB);
            PG8_BAR; PG8_WAIT_L(0); PG8_MMA(0, 1, At, B1); PG8_BAR;
            PG8_LDA(At, 0, 1); PG8_STAGE(PG8_SA(0, 0), a2, voffA);
            PG8_BAR; PG8_WAIT_L(0); PG8_MMA(1, 0, At, B0); PG8_BAR; PG8_SCHED;
            PG8_STAGE(PG8_SB(0, 1), b2 + hstep, voffB);
            PG8_WAIT_V(6); PG8_BAR; PG8_MMA(1, 1, At, B1); PG8_BAR;
            PG8_LDB(B0, 1, 0); PG8_SCHED; PG8_LDA(At, 1, 0); PG8_STAGE(PG8_SA(0, 1), a2 + hstep, voffA);
            PG8_WAIT_L(8); PG8_BAR; PG8_WAIT_L(0); PG8_MMA(0, 0, At, B0); PG8_BAR; PG8_SCHED;
            PG8_LDB(B1, 1, 1); PG8_STAGE(PG8_SB(1, 0), b3, voffB);
            PG8_BAR; PG8_WAIT_L(0); PG8_MMA(0, 1, At, B1); PG8_BAR;
            PG8_LDA(At, 1, 1); PG8_STAGE(PG8_SA(1, 0), a3, voffA);
            PG8_BAR; PG8_WAIT_L(0); PG8_MMA(1, 0, At, B0); PG8_BAR; PG8_SCHED;
            PG8_STAGE(PG8_SB(1, 1), b3 + hstep, voffB);
            PG8_WAIT_V(6); PG8_BAR; PG8_MMA(1, 1, At, B1); PG8_BAR;
            }
        }
        if constexpr (ALIGN_EPI) { if (wr == 0) PG8_BAR; }
        if constexpr (!Epi::AFTER_DRAIN) { E(acc, cur, wr, wc, fr, fq); S.done(cur); }
        if (!has_next) break;
#pragma unroll
        for (int a = 0; a < 2; ++a)
#pragma unroll
            for (int b = 0; b < 2; ++b)
#pragma unroll
                for (int m = 0; m < 4; ++m)
#pragma unroll
                    for (int n = 0; n < 2; ++n) acc[a][b][m][n] = (f32x4){0.f, 0.f, 0.f, 0.f};
        cur = nxt; cA = nA; cB = nB; ++ui;
        if constexpr (ALIGN_EPI) { if (wr == 1) PG8_BAR; }
    }
    PG8_WAIT_V(0);
    if constexpr (!ALIGN_EPI) { if (wr == 0) PG8_BAR; }
    PG8_BAR;
    if constexpr (Epi::AFTER_DRAIN) { E.fused(acc, cur, wr, wc, fr, fq, lds, wid, lane); S.done(cur); }
#undef PG8_SA
#undef PG8_SB
#undef PG8_STAGE
#undef PG8_LDA
#undef PG8_LDB
#undef PG8_MMA
#undef PG8_WAIT_V
#undef PG8_WAIT_L
#undef PG8_BAR
#undef PG8_SCHED
}
}

namespace cg = cooperative_groups;
#define LAS __attribute__((address_space(3)))
typedef unsigned short bf16;
typedef float f32x4 __attribute__((ext_vector_type(4)));
typedef float f32x2 __attribute__((ext_vector_type(2)));
typedef short bf16x8 __attribute__((ext_vector_type(8)));
typedef unsigned u32x4 __attribute__((ext_vector_type(4)));
typedef unsigned u32x2 __attribute__((ext_vector_type(2)));

constexpr int NT = 65536, DM = 1024, SEQ = 4096, NB = 16, DEPTH = 4;
constexpr int P_EVEN = 2816, P_A = 1792, P_ODD = 1536, FF = 2816;
constexpr int NTHREADS = 512, NWAVES = 8;
constexpr int LDS_BYTES = 147456;
constexpr int XB_LDS_OFF = LDS_BYTES - 64;

constexpr size_t MiB = 1u << 20;
constexpr size_t WS_EVIN = 0;
constexpr size_t WS_ODIN = 11 * MiB;
constexpr size_t WS_WOUT = 17 * MiB;
constexpr size_t WS_GU   = 25 * MiB;
constexpr size_t WS_DN   = 69 * MiB;
constexpr size_t WS_SPW  = 91 * MiB;
constexpr size_t WS_GUPT = WS_SPW + 256 * 1024;
constexpr size_t WS_WUPT = WS_GUPT + 256 * 1024;
constexpr size_t WS_AUPT = WS_WUPT + 128 * 1024;
constexpr size_t WS_BON  = 92 * MiB;
constexpr size_t WS_HN   = 96 * MiB;
constexpr size_t WS_PROJ = 224 * MiB;
constexpr size_t WS_YCAT = 576 * MiB;
constexpr size_t WS_YS   = 704 * MiB;
constexpr size_t WS_H    = 832 * MiB;
constexpr size_t WS_CTL  = 960 * MiB;
constexpr size_t WS_CNT  = WS_CTL + 16384;
constexpr size_t WS_XB   = WS_CTL + 262144;
constexpr size_t WS_SSP  = 964 * MiB;
constexpr size_t WS_END  = 968 * MiB;

struct Args { const float* in[32]; float* out; unsigned char* ws; };

__device__ __forceinline__ unsigned f2bf(float f) { unsigned u = __builtin_bit_cast(unsigned, f); return (u + 0x7fffu + ((u >> 16) & 1u)) >> 16; }
__device__ __forceinline__ unsigned pk2(float lo, float hi) { unsigned r; asm volatile("v_cvt_pk_bf16_f32 %0, %1, %2" : "=v"(r) : "v"(lo), "v"(hi)); return r; }
__device__ __forceinline__ float bflo(unsigned w) { return __builtin_bit_cast(float, w << 16); }
__device__ __forceinline__ float bfhi(unsigned w) { return __builtin_bit_cast(float, w & 0xffff0000u); }
__device__ __forceinline__ float bf1(bf16 b) { return __builtin_bit_cast(float, ((unsigned)b) << 16); }
__device__ __forceinline__ float sigmoidf_(float x) { return __builtin_amdgcn_rcpf(1.0f + __builtin_amdgcn_exp2f(-1.44269504f * x)); }

template <int CTRL> __device__ __forceinline__ float dppf(float x) { const int v = __builtin_bit_cast(int, x); return __builtin_bit_cast(float, __builtin_amdgcn_update_dpp(v, v, CTRL, 0xF, 0xF, true)); }
__device__ __forceinline__ float sum8(float x)  { x += dppf<0xB1>(x); x += dppf<0x4E>(x); x += dppf<0x141>(x); return x; }
__device__ __forceinline__ float sum16(float x) { x += dppf<0xB1>(x); x += dppf<0x4E>(x); x += dppf<0x141>(x); x += dppf<0x140>(x); return x; }
__device__ __forceinline__ float rdl(float x, int l) { return __builtin_bit_cast(float, __builtin_amdgcn_readlane(__builtin_bit_cast(int, x), l)); }
__device__ __forceinline__ float wave_sum(float v) { v = sum16(v); return (rdl(v, 0) + rdl(v, 16)) + (rdl(v, 32) + rdl(v, 48)); }
__device__ __forceinline__ float shx(float v, int lane, int o) { return __builtin_bit_cast(float, __builtin_amdgcn_ds_bpermute((lane ^ o) << 2, __builtin_bit_cast(int, v))); }
#define LDS_WAIT() asm volatile("s_waitcnt lgkmcnt(0)" ::: "memory")

__device__ __forceinline__ void transpose_item(const float* W, int ldw, int k0, int n0, bf16* WT, int ldt, int drow0, LAS float* scr, int lane, const float* kscale = nullptr) {
#pragma unroll 8
    for (int i = 0; i < 32; ++i) { const int kk = 2 * i + (lane >> 5); const float sc = kscale ? kscale[k0 + kk] : 1.0f; scr[kk * 33 + (lane & 31)] = W[(size_t)(k0 + kk) * ldw + n0 + (lane & 31)] * sc; }
    LDS_WAIT(); asm volatile("" ::: "memory");
    const int c = lane & 7;
#pragma unroll
    for (int j = 0; j < 4; ++j) { const int n = (lane >> 3) + 8 * j; const LAS float* s = scr + (8 * c) * 33 + n;
        u32x4 o; o.x = pk2(s[0 * 33], s[1 * 33]); o.y = pk2(s[2 * 33], s[3 * 33]); o.z = pk2(s[4 * 33], s[5 * 33]); o.w = pk2(s[6 * 33], s[7 * 33]);
        *(u32x4*)(WT + (size_t)(drow0 + n) * ldt + k0 + 8 * c) = o; }
    LDS_WAIT(); asm volatile("" ::: "memory");
}

__device__ __forceinline__ void prep_phase(const Args& a, LAS unsigned char* lds) {
    int tid_ = threadIdx.x; asm volatile("" : "+v"(tid_)); const int tid = tid_, lane = tid & 63, wave = tid >> 6;
    LAS float* scr = (LAS float*)(lds + wave * 8704);
    const int gw = blockIdx.x * NWAVES + wave, NGW = gridDim.x * NWAVES;
    unsigned char* ws = a.ws;
    constexpr int I_EVIN = 16 * 88, I_ODIN = 16 * 48, I_EVO = 16 * 32, I_ODO = 8 * 32, I_GU = 16 * 88, I_DN = 44 * 32, I_LW = 16, I_LG = 32;
    constexpr int NITEMS = 2 * I_EVIN + 2 * I_ODIN + 2 * I_EVO + 2 * I_ODO + 8 * I_GU + 4 * I_DN + 4 * I_LW + 2 * I_LG;
    for (int it = gw; it < NITEMS; it += NGW) {
        int r = it;
        if (r < 2 * I_EVIN) { const int i = r / I_EVIN; r %= I_EVIN; const int kb = r / 88, nb = r % 88;
            transpose_item(a.in[4] + (size_t)i * DM * P_EVEN, P_EVEN, kb * 64, nb * 32, (bf16*)(ws + WS_EVIN) + (size_t)i * P_EVEN * DM, DM, nb * 32, scr, lane, a.in[1] + (2 * i) * DM); continue; } r -= 2 * I_EVIN;
        if (r < 2 * I_ODIN) { const int i = r / I_ODIN; r %= I_ODIN; const int kb = r / 48, nb = r % 48;
            transpose_item(a.in[21] + (size_t)i * DM * P_ODD, P_ODD, kb * 64, nb * 32, (bf16*)(ws + WS_ODIN) + (size_t)i * P_ODD * DM, DM, nb * 32, scr, lane, a.in[1] + (2 * i + 1) * DM); continue; } r -= 2 * I_ODIN;
        if (r < 2 * I_EVO) { const int i = r / I_EVO; r %= I_EVO; const int kb = r / 32, nb = r % 32;
            transpose_item(a.in[20] + (size_t)i * DM * DM, DM, kb * 64, nb * 32, (bf16*)(ws + WS_WOUT) + (size_t)(2 * i) * DM * DM, DM, nb * 32, scr, lane); continue; } r -= 2 * I_EVO;
        if (r < 2 * I_ODO) { const int i = r / I_ODO; r %= I_ODO; const int kb = r / 32, nb = r % 32;
            transpose_item(a.in[28] + (size_t)i * DM * DM, DM, kb * 64, nb * 32, (bf16*)(ws + WS_WOUT) + (size_t)(2 * i + 1) * DM * DM, DM, nb * 32, scr, lane); continue; } r -= 2 * I_ODO;
        if (r < 8 * I_GU) { const int l = r / (2 * I_GU); r %= 2 * I_GU; const int up = r / I_GU; r %= I_GU; const int kb = r / 88, nb = r % 88; const int n0 = nb * 32;
            transpose_item((up ? a.in[30] : a.in[29]) + (size_t)l * DM * FF, FF, kb * 64, n0, (bf16*)(ws + WS_GU) + (size_t)l * 2 * FF * DM, DM, (n0 >> 7) * 256 + (n0 & 127) + up * 128, scr, lane); continue; } r -= 8 * I_GU;
        if (r < 4 * I_DN) { const int l = r / I_DN; r %= I_DN; const int kb = r / 32, nb = r % 32;
            transpose_item(a.in[31] + (size_t)l * FF * DM, DM, kb * 64, nb * 32, (bf16*)(ws + WS_DN) + (size_t)l * DM * FF, FF, nb * 32, scr, lane); continue; } r -= 4 * I_DN;
        if (r < 4 * I_LW) { const int which = r / (2 * I_LW); r %= 2 * I_LW; const int i = r / I_LW; const int nb = r % I_LW;
            transpose_item((which ? a.in[9] : a.in[7]) + (size_t)i * 64 * 512, 512, 0, nb * 32, (bf16*)(ws + (which ? WS_AUPT : WS_WUPT)) + (size_t)i * 512 * 64, 64, nb * 32, scr, lane); continue; } r -= 4 * I_LW;
        { const int i = r / I_LG; r %= I_LG; const int kb = r / 16, nb = r % 16;
            transpose_item(a.in[10] + (size_t)i * 128 * 512, 512, kb * 64, nb * 32, (bf16*)(ws + WS_GUPT) + (size_t)i * 512 * 128, 128, nb * 32, scr, lane); }
    }
    const int gt = blockIdx.x * NTHREADS + tid, NGT = gridDim.x * NTHREADS;
    for (int e = gt; e < 2 * 4 * 128 * 128; e += NGT) { const int j = e & 127, i = (e >> 7) & 127; const float v = (j <= i) ? a.in[18][e] : 0.f; ((bf16*)(ws + WS_SPW))[e] = (bf16)f2bf(v); }
    for (int e = gt; e < 2 * 1024 * 4 * 16; e += NGT) {
        const int o = e & 1023, ib = (e >> 10) & 15, g = (e >> 14) & 3, i = e >> 16;
        const float* pw = a.in[26] + ((size_t)(i * 4 + g) * 128 + ib * 8) * 128; const float* sc = a.in[27] + i * 512 + g * 128; const float* wo = a.in[28] + (size_t)i * DM * DM + (size_t)(512 + g * 128) * DM + o;
        float acc[8];
#pragma unroll
        for (int q = 0; q < 8; ++q) acc[q] = 0.f;
        for (int j = 0; j < 128; ++j) { const float wv = wo[(size_t)j * DM] * sc[j];
#pragma unroll
            for (int q = 0; q < 8; ++q) acc[q] += pw[q * 128 + j] * wv; }
        u32x4 w; w.x = pk2(acc[0], acc[1]); w.y = pk2(acc[2], acc[3]); w.z = pk2(acc[4], acc[5]); w.w = pk2(acc[6], acc[7]);
        *(u32x4*)((bf16*)(ws + WS_WOUT) + (size_t)(2 * i + 1) * DM * DM + (size_t)o * DM + 512 + g * 128 + ib * 8) = w;
    }
}

__device__ __forceinline__ void rmsnorm_phase(const float* __restrict__ xin, const bf16* __restrict__ hb, const float* __restrict__ g, bf16* __restrict__ hn, bf16* __restrict__ hstream) {
    int tid_ = threadIdx.x; asm volatile("" : "+v"(tid_)); const int lane = tid_ & 63, wave = tid_ >> 6; const int gw = blockIdx.x * NWAVES + wave, NGW = gridDim.x * NWAVES;
    f32x4 gv[4];
#pragma unroll
    for (int j = 0; j < 4; ++j) gv[j] = ((const f32x4*)g)[lane + 64 * j];
    if (xin) {
        for (int m = gw; m < NT; m += NGW) {
            f32x4 v[4]; float s = 0.f; const f32x4* xr = (const f32x4*)(xin + (size_t)m * DM) + lane;
#pragma unroll
            for (int j = 0; j < 4; ++j) v[j] = xr[64 * j];
#pragma unroll
            for (int j = 0; j < 4; ++j) s += (v[j].x * v[j].x + v[j].y * v[j].y) + (v[j].z * v[j].z + v[j].w * v[j].w);
            const float ssum = wave_sum(s); const float r = 0.f;
            u32x2* s8 = (u32x2*)(hstream + (size_t)m * DM) + lane; (void)r;
#pragma unroll
            for (int j = 0; j < 4; ++j) { u32x2 q; q.x = pk2(v[j].x, v[j].y); q.y = pk2(v[j].z, v[j].w); s8[64 * j] = q; }
            if (lane < 16) ((float*)hn)[(size_t)m * 16 + lane] = (lane == 0) ? ssum : 0.f;
        }
    } else {
        for (int m = gw; m < NT; m += 4 * NGW) {
            u32x2 w[4][4];
#pragma unroll
            for (int q = 0; q < 4; ++q) { const u32x2* xr = (const u32x2*)(hb + (size_t)(m + q * NGW) * DM) + lane;
#pragma unroll
                for (int j = 0; j < 4; ++j) w[q][j] = (m + q * NGW < NT) ? xr[64 * j] : (u32x2){0u, 0u}; }
#pragma unroll
            for (int q = 0; q < 4; ++q) { f32x4 v[4]; float s = 0.f;
#pragma unroll
                for (int j = 0; j < 4; ++j) { v[j] = (f32x4){bflo(w[q][j].x), bfhi(w[q][j].x), bflo(w[q][j].y), bfhi(w[q][j].y)}; s += (v[j].x * v[j].x + v[j].y * v[j].y) + (v[j].z * v[j].z + v[j].w * v[j].w); }
                const float r = 1.0f / sqrtf(wave_sum(s) * (1.f / DM) + 1e-5f);
                u32x2* o8 = (u32x2*)(hn + (size_t)(m + q * NGW) * DM) + lane;
#pragma unroll
                for (int j = 0; j < 4; ++j) { u32x2 o; o.x = pk2(v[j].x * r * gv[j].x, v[j].y * r * gv[j].y); o.y = pk2(v[j].z * r * gv[j].z, v[j].w * r * gv[j].w); if (m + q * NGW < NT) o8[64 * j] = o; } }
        }
    }
}
__device__ __forceinline__ void final_norm_phase(const bf16* hb, float* out, const float* g) {
    int tid_ = threadIdx.x; asm volatile("" : "+v"(tid_)); const int lane = tid_ & 63, wave = tid_ >> 6; const int gw = blockIdx.x * NWAVES + wave, NGW = gridDim.x * NWAVES;
    f32x4 gv[4];
#pragma unroll
    for (int j = 0; j < 4; ++j) gv[j] = ((const f32x4*)g)[lane + 64 * j];
    for (int m = gw; m < NT; m += NGW) {
        const u32x2* xr = (const u32x2*)(hb + (size_t)m * DM) + lane; f32x4 v[4]; float s = 0.f;
#pragma unroll
        for (int j = 0; j < 4; ++j) { const u32x2 w = xr[64 * j]; v[j] = (f32x4){bflo(w.x), bfhi(w.x), bflo(w.y), bfhi(w.y)}; s += (v[j].x * v[j].x + v[j].y * v[j].y) + (v[j].z * v[j].z + v[j].w * v[j].w); }
        const float r = 1.0f / sqrtf(wave_sum(s) * (1.f / DM) + 1e-5f);
        f32x4* orow = (f32x4*)(out + (size_t)m * DM) + lane;
#pragma unroll
        for (int j = 0; j < 4; ++j) orow[64 * j] = v[j] * r * gv[j];
    }
}

constexpr int SC_L = 32;
constexpr int SB_R = 0, SB_W = 8192, SB_K = 16384, SB_V = 24576, SB_KK = 32768, SB_B = 40960, SB_SIZE = 49152;
constexpr int SC_KRAW = 2 * SB_SIZE;
constexpr int SC_TW = SC_KRAW + 8192, SC_AD = SC_TW + 32 * 144;
constexpr int SC_WUP = SC_AD + 32 * 144, SC_AUP = SC_WUP + 64 * 144;
constexpr int SC_Y = SC_AUP + 64 * 144;
constexpr int SC_BON = SC_Y + 2 * 4096;
constexpr int SC_CNT = SC_BON + 512;
static_assert(SC_CNT + 16 <= LDS_BYTES, "scan LDS");

#define LERP1(c, p, m) ((c) + ((p) - (c)) * (m))
__device__ __forceinline__ float rs_from16(const float* p) { const f32x4 a = *(const f32x4*)p, b = *(const f32x4*)(p + 4), c = *(const f32x4*)(p + 8), d = *(const f32x4*)(p + 12);
    return __builtin_amdgcn_rsqf(((((a.x + a.y) + (a.z + a.w)) + ((b.x + b.y) + (b.z + b.w))) + (((c.x + c.y) + (c.z + c.w)) + ((d.x + d.y) + (d.z + d.w)))) * (1.0f / 1024.0f) + 1e-5f); }
struct StepVec { f32x4 kA, kB, wA, wB, bA, bB, cA, cB, rA, rB; float vv; };
__device__ __forceinline__ void unpack8(const u32x4 w, float (&x)[8]) { x[0] = bflo(w.x); x[1] = bfhi(w.x); x[2] = bflo(w.y); x[3] = bfhi(w.y); x[4] = bflo(w.z); x[5] = bfhi(w.z); x[6] = bflo(w.w); x[7] = bfhi(w.w); }

__device__ __forceinline__ void scan_phase(const Args& a, int li, LAS unsigned char* lds) {
    unsigned char* wsl = a.ws; asm volatile("" : "+s"(wsl));
    int tid_ = threadIdx.x; asm volatile("" : "+v"(tid_)); const int tid = tid_, lane = tid & 63, wave = __builtin_amdgcn_readfirstlane(tid >> 6);
    const bf16* proj = (const bf16*)(wsl + WS_PROJ); float* ys = (float*)(wsl + WS_YS); float* bong = (float*)(wsl + WS_BON);
    const float* mu = a.in[5] + li * P_A; const float* w0 = a.in[6] + li * 512; const float* a0 = a.in[8] + li * 512;
    const float* k_k = a.in[11] + li * 512; const float* k_a = a.in[12] + li * 512; const float* r_k = a.in[13] + li * 512;
    for (int unit = blockIdx.x; unit < 256; unit += gridDim.x) {
        const int half = unit & 1, bh = unit >> 1, h = bh & 7, b = bh >> 3;
        { const int row = tid >> 3, seg = tid & 7;
          *(LAS u32x4*)(lds + SC_WUP + row * 144 + seg * 16) = *(const u32x4*)((const bf16*)(wsl + WS_WUPT) + (size_t)li * 512 * 64 + (size_t)(64 * h + row) * 64 + seg * 8);
          *(LAS u32x4*)(lds + SC_AUP + row * 144 + seg * 16) = *(const u32x4*)((const bf16*)(wsl + WS_AUPT) + (size_t)li * 512 * 64 + (size_t)(64 * h + row) * 64 + seg * 8);
          if (tid == 0) *(LAS unsigned*)(lds + SC_CNT) = 0u; }
        __syncthreads();
        if (wave >= 4) {
            const int pw = wave - 4, tb = pw >> 1, jh = pw & 1, ptid = tid - 256;
            const int tl = lane >> 3, q8 = lane & 7; const int t1 = pw * 8 + tl;
            const int cR = 64 * h + 8 * q8, cK = 512 + cR, cV = 1024 + cR, cWD = 1536 + 8 * q8, cAD = 1600 + 8 * q8;
            const int n2 = lane & 15, q2 = lane >> 4; const int t2 = tb * 16 + n2;
            u32x4 cur[5], prv[5]; f32x2 pcur, pprv; const float* sspc = (const float*)(wsl + WS_SSP);
#define SC_FETCH(cc_) do { const int p0_ = (cc_) * SC_L; const bf16* projc = proj; asm volatile("" : "+s"(projc)); const bf16* rp = projc + ((size_t)b * SEQ + p0_ + t1) * P_EVEN; \
                cur[0] = *(const u32x4*)(rp + cR); cur[1] = *(const u32x4*)(rp + cK); cur[2] = *(const u32x4*)(rp + cV); cur[3] = *(const u32x4*)(rp + cWD); cur[4] = *(const u32x4*)(rp + cAD); \
                _Pragma("unroll") for (int g = 0; g < 5; ++g) prv[g] = (u32x4){0u, 0u, 0u, 0u}; \
                { const float* sp_ = sspc + ((size_t)b * SEQ + p0_ + t1) * 16 + 2 * q8; pcur = *(const f32x2*)sp_; pprv = (f32x2){512.f, 512.f}; \
                if (p0_ + t1 > 0) { const bf16* pp = rp - P_EVEN; prv[0] = *(const u32x4*)(pp + cR); prv[1] = *(const u32x4*)(pp + cK); prv[2] = *(const u32x4*)(pp + cV); prv[3] = *(const u32x4*)(pp + cWD); prv[4] = *(const u32x4*)(pp + cAD); pprv = *(const f32x2*)(sp_ - 16); } } } while (0)
            SC_FETCH(0);
            for (int cc = 0; cc <= SEQ / SC_L; ++cc) {
                if (cc < SEQ / SC_L) {
                    const int bo = (cc & 1) * SB_SIZE; const int t = t1;
                    { float c8[8], p8[8], o[8], m8[8], kk8[8];
                        const float rsc = __builtin_amdgcn_rsqf(sum8(pcur.x + pcur.y) * (1.0f / 1024.0f) + 1e-5f), rsp = __builtin_amdgcn_rsqf(sum8(pprv.x + pprv.y) * (1.0f / 1024.0f) + 1e-5f);
                        { const f32x4 m0_ = *(const f32x4*)(mu + cR), m1_ = *(const f32x4*)(mu + cR + 4); m8[0] = m0_.x; m8[1] = m0_.y; m8[2] = m0_.z; m8[3] = m0_.w; m8[4] = m1_.x; m8[5] = m1_.y; m8[6] = m1_.z; m8[7] = m1_.w; }
                        unpack8(cur[0], c8); unpack8(prv[0], p8);
#pragma unroll
                        for (int e = 0; e < 8; ++e) { c8[e] *= rsc; p8[e] *= rsp; }
#pragma unroll
                        for (int e = 0; e < 8; ++e) o[e] = LERP1(c8[e], p8[e], m8[e]);
                        *(LAS f32x4*)(lds + bo + SB_R + t * 256 + q8 * 32) = (f32x4){o[0], o[1], o[2], o[3]}; *(LAS f32x4*)(lds + bo + SB_R + t * 256 + q8 * 32 + 16) = (f32x4){o[4], o[5], o[6], o[7]};
                        { const f32x4 m0_ = *(const f32x4*)(mu + cV), m1_ = *(const f32x4*)(mu + cV + 4); m8[0] = m0_.x; m8[1] = m0_.y; m8[2] = m0_.z; m8[3] = m0_.w; m8[4] = m1_.x; m8[5] = m1_.y; m8[6] = m1_.z; m8[7] = m1_.w; }
                        unpack8(cur[2], c8); unpack8(prv[2], p8);
#pragma unroll
                        for (int e = 0; e < 8; ++e) { c8[e] *= rsc; p8[e] *= rsp; }
#pragma unroll
                        for (int e = 0; e < 8; ++e) o[e] = LERP1(c8[e], p8[e], m8[e]);
                        *(LAS f32x4*)(lds + bo + SB_V + t * 256 + q8 * 32) = (f32x4){o[0], o[1], o[2], o[3]}; *(LAS f32x4*)(lds + bo + SB_V + t * 256 + q8 * 32 + 16) = (f32x4){o[4], o[5], o[6], o[7]};
                        { const f32x4 m0_ = *(const f32x4*)(mu + cK), m1_ = *(const f32x4*)(mu + cK + 4); m8[0] = m0_.x; m8[1] = m0_.y; m8[2] = m0_.z; m8[3] = m0_.w; m8[4] = m1_.x; m8[5] = m1_.y; m8[6] = m1_.z; m8[7] = m1_.w; } { const f32x4 m0_ = *(const f32x4*)(k_k + cR), m1_ = *(const f32x4*)(k_k + cR + 4); kk8[0] = m0_.x; kk8[1] = m0_.y; kk8[2] = m0_.z; kk8[3] = m0_.w; kk8[4] = m1_.x; kk8[5] = m1_.y; kk8[6] = m1_.z; kk8[7] = m1_.w; }
                        unpack8(cur[1], c8); unpack8(prv[1], p8);
#pragma unroll
                        for (int e = 0; e < 8; ++e) { c8[e] *= rsc; p8[e] *= rsp; } float ss = 0.f;
#pragma unroll
                        for (int e = 0; e < 8; ++e) { o[e] = LERP1(c8[e], p8[e], m8[e]); c8[e] = o[e] * kk8[e]; ss += c8[e] * c8[e]; }
                        *(LAS f32x4*)(lds + SC_KRAW + t * 256 + q8 * 32) = (f32x4){o[0], o[1], o[2], o[3]}; *(LAS f32x4*)(lds + SC_KRAW + t * 256 + q8 * 32 + 16) = (f32x4){o[4], o[5], o[6], o[7]};
                        ss = sum8(ss); const float inv = 1.0f / fmaxf(sqrtf(ss), 1e-12f);
                        *(LAS f32x4*)(lds + bo + SB_KK + t * 256 + q8 * 32) = (f32x4){c8[0] * inv, c8[1] * inv, c8[2] * inv, c8[3] * inv}; *(LAS f32x4*)(lds + bo + SB_KK + t * 256 + q8 * 32 + 16) = (f32x4){c8[4] * inv, c8[5] * inv, c8[6] * inv, c8[7] * inv};
                        { const f32x4 m0_ = *(const f32x4*)(mu + cWD), m1_ = *(const f32x4*)(mu + cWD + 4); m8[0] = m0_.x; m8[1] = m0_.y; m8[2] = m0_.z; m8[3] = m0_.w; m8[4] = m1_.x; m8[5] = m1_.y; m8[6] = m1_.z; m8[7] = m1_.w; }
                        unpack8(cur[3], c8); unpack8(prv[3], p8);
#pragma unroll
                        for (int e = 0; e < 8; ++e) { c8[e] *= rsc; p8[e] *= rsp; }
#pragma unroll
                        for (int e = 0; e < 8; ++e) { const float xw = LERP1(c8[e], p8[e], m8[e]); o[e] = 1.0f - 2.0f * __builtin_amdgcn_rcpf(1.0f + __builtin_amdgcn_exp2f(2.88539008f * xw)); }
                        { u32x4 w; w.x = pk2(o[0], o[1]); w.y = pk2(o[2], o[3]); w.z = pk2(o[4], o[5]); w.w = pk2(o[6], o[7]); *(LAS u32x4*)(lds + SC_TW + t * 144 + q8 * 16) = w; }
                        { const f32x4 m0_ = *(const f32x4*)(mu + cAD), m1_ = *(const f32x4*)(mu + cAD + 4); m8[0] = m0_.x; m8[1] = m0_.y; m8[2] = m0_.z; m8[3] = m0_.w; m8[4] = m1_.x; m8[5] = m1_.y; m8[6] = m1_.z; m8[7] = m1_.w; }
                        unpack8(cur[4], c8); unpack8(prv[4], p8);
#pragma unroll
                        for (int e = 0; e < 8; ++e) { c8[e] *= rsc; p8[e] *= rsp; }
#pragma unroll
                        for (int e = 0; e < 8; ++e) o[e] = LERP1(c8[e], p8[e], m8[e]);
                        { u32x4 w; w.x = pk2(o[0], o[1]); w.y = pk2(o[2], o[3]); w.z = pk2(o[4], o[5]); w.w = pk2(o[6], o[7]); *(LAS u32x4*)(lds + SC_AD + t * 144 + q8 * 16) = w; } }
                    if (cc + 1 < SEQ / SC_L) SC_FETCH(cc + 1);
                    LDS_WAIT();
                    if (lane == 0) __hip_atomic_fetch_add((LAS unsigned*)(lds + SC_CNT), 1u, __ATOMIC_RELAXED, __HIP_MEMORY_SCOPE_WORKGROUP);
                    while (__hip_atomic_load((LAS unsigned*)(lds + SC_CNT), __ATOMIC_RELAXED, __HIP_MEMORY_SCOPE_WORKGROUP) < 4u * (unsigned)(cc + 1)) __builtin_amdgcn_s_sleep(1);
                    asm volatile("" ::: "memory");
                    float bp = 0.f;
#pragma unroll
                    for (int jbi = 0; jbi < 2; ++jbi) { const int jb = 2 * jh + jbi, j2 = jb * 16 + 4 * q2;
                        f32x4 accw = {0.f, 0.f, 0.f, 0.f}, acca = {0.f, 0.f, 0.f, 0.f};
#pragma unroll
                        for (int ks = 0; ks < 2; ++ks) {
                            const bf16x8 Aw = *(const LAS bf16x8*)(lds + SC_WUP + (jb * 16 + n2) * 144 + (8 * q2 + 32 * ks) * 2), Aa = *(const LAS bf16x8*)(lds + SC_AUP + (jb * 16 + n2) * 144 + (8 * q2 + 32 * ks) * 2);
                            const bf16x8 Bw = *(const LAS bf16x8*)(lds + SC_TW + t2 * 144 + (8 * q2 + 32 * ks) * 2), Ba = *(const LAS bf16x8*)(lds + SC_AD + t2 * 144 + (8 * q2 + 32 * ks) * 2);
                            accw = __builtin_amdgcn_mfma_f32_16x16x32_bf16(Aw, Bw, accw, 0, 0, 0); acca = __builtin_amdgcn_mfma_f32_16x16x32_bf16(Aa, Ba, acca, 0, 0, 0); }
                        const f32x4 w0v = *(const f32x4*)(w0 + 64 * h + j2), a0v = *(const f32x4*)(a0 + 64 * h + j2), kav = *(const f32x4*)(k_a + 64 * h + j2), rkv = *(const f32x4*)(r_k + 64 * h + j2);
                        const f32x4 kraw = *(const LAS f32x4*)(lds + SC_KRAW + t2 * 256 + j2 * 4), kkn = *(const LAS f32x4*)(lds + bo + SB_KK + t2 * 256 + j2 * 4), rr = *(const LAS f32x4*)(lds + bo + SB_R + t2 * 256 + j2 * 4);
                        f32x4 dec, bb, km;
#pragma unroll
                        for (int e = 0; e < 4; ++e) { const float wp = w0v[e] + accw[e]; dec[e] = __expf(-0.60653066f * sigmoidf_(wp));
                            const float av = sigmoidf_(a0v[e] + acca[e]); km[e] = kraw[e] * (1.0f + (av - 1.0f) * kav[e]); bb[e] = kkn[e] * av; bp += rr[e] * km[e] * rkv[e]; }
                        *(LAS f32x4*)(lds + bo + SB_W + t2 * 256 + j2 * 4) = dec; *(LAS f32x4*)(lds + bo + SB_B + t2 * 256 + j2 * 4) = bb; *(LAS f32x4*)(lds + bo + SB_K + t2 * 256 + j2 * 4) = km; }
                    bp += shx(bp, lane, 16); bp += shx(bp, lane, 32);
                    if (lane < 16) *(LAS float*)(lds + SC_BON + (cc & 1) * 256 + t2 * 8 + jh * 4) = bp;
                }
                if (cc >= 2) { const int pc = cc - 2; const size_t growp = (size_t)b * SEQ + pc * SC_L; const int t = ptid >> 3, seg = ptid & 7;
                    *(f32x4*)(ys + (growp + t) * 512 + 64 * h + 32 * half + 4 * seg) = *(const LAS f32x4*)(lds + SC_Y + (pc & 1) * 4096 + t * 128 + seg * 16); }
                if (cc >= 1 && half == 0 && ptid < 32) { const int pc = cc - 1; const f32x2 bq = *(const LAS f32x2*)(lds + SC_BON + (pc & 1) * 256 + ptid * 8);
                    bong[((size_t)b * SEQ + pc * SC_L + ptid) * 8 + h] = bq.x + bq.y; }
                __syncthreads();
            }
        } else {
            const int rl = wave * 8 + (lane >> 3), cgp = lane & 7, rowg = half * 32 + rl;
            f32x2 s0 = {0.f, 0.f}, s1 = {0.f, 0.f}, s2 = {0.f, 0.f}, s3 = {0.f, 0.f};
            __syncthreads();
            for (int c = 0; c < SEQ / SC_L; ++c) {
                const int bo = (c & 1) * SB_SIZE; const LAS unsigned char* vb = lds + bo + cgp * 32; const LAS unsigned char* vrow = lds + bo + SB_V + rowg * 4;
#define SC_LOADV(V, t) do { V.kA = *(const LAS f32x4*)(vb + SB_KK + (t) * 256); V.kB = *(const LAS f32x4*)(vb + SB_KK + (t) * 256 + 16); V.wA = *(const LAS f32x4*)(vb + SB_W + (t) * 256); V.wB = *(const LAS f32x4*)(vb + SB_W + (t) * 256 + 16); \
        V.bA = *(const LAS f32x4*)(vb + SB_B + (t) * 256); V.bB = *(const LAS f32x4*)(vb + SB_B + (t) * 256 + 16); V.cA = *(const LAS f32x4*)(vb + SB_K + (t) * 256); V.cB = *(const LAS f32x4*)(vb + SB_K + (t) * 256 + 16); \
        V.rA = *(const LAS f32x4*)(vb + SB_R + (t) * 256); V.rB = *(const LAS f32x4*)(vb + SB_R + (t) * 256 + 16); V.vv = *(const LAS float*)(vrow + (t) * 256); } while (0)
#define SB_ __builtin_amdgcn_sched_barrier(0)
#define SC_LD1(L, f, OFF, tl) L.f = *(const LAS f32x4*)(vb + (OFF) + (tl) * 256)
#define SC_STEPF(C, L, tl, jprev) do { \
        const f32x2 vv2 = {C.vv, C.vv}; f32x2 p, vk0, vk1, vk2, vk3, t0, t1, t2, t3, q; float pa; \
        p = s0 * (f32x2){C.kA.x, C.kA.y}; SB_; vk0 = vv2 * (f32x2){C.cA.x, C.cA.y}; SB_; qprev += dppf<0xB1>(qprev); SB_; \
        p = __builtin_elementwise_fma(s1, (f32x2){C.kA.z, C.kA.w}, p); SB_; vk1 = vv2 * (f32x2){C.cA.z, C.cA.w}; SB_; qprev += dppf<0x4E>(qprev); SB_; \
        p = __builtin_elementwise_fma(s2, (f32x2){C.kB.x, C.kB.y}, p); SB_; vk2 = vv2 * (f32x2){C.cB.x, C.cB.y}; SB_; qprev += dppf<0x141>(qprev); SB_; \
        p = __builtin_elementwise_fma(s3, (f32x2){C.kB.z, C.kB.w}, p); SB_; vk3 = vv2 * (f32x2){C.cB.z, C.cB.w}; SB_; yk = (cgp == (jprev)) ? qprev : yk; SB_; \
        pa = p.x + p.y; SB_; \
        SC_LD1(L, kA, SB_KK, tl); SB_; SC_LD1(L, kB, SB_KK + 16, tl); SB_; pa += dppf<0xB1>(pa); SB_; \
        SC_LD1(L, wA, SB_W, tl); SB_; SC_LD1(L, wB, SB_W + 16, tl); SB_; pa += dppf<0x4E>(pa); SB_; \
        SC_LD1(L, bA, SB_B, tl); SB_; SC_LD1(L, bB, SB_B + 16, tl); SB_; pa += dppf<0x141>(pa); SB_; \
        { const float sa = -pa; const f32x2 sa2 = {sa, sa}; \
          t0 = __builtin_elementwise_fma(sa2, (f32x2){C.bA.x, C.bA.y}, vk0); SB_; t1 = __builtin_elementwise_fma(sa2, (f32x2){C.bA.z, C.bA.w}, vk1); SB_; \
          t2 = __builtin_elementwise_fma(sa2, (f32x2){C.bB.x, C.bB.y}, vk2); SB_; t3 = __builtin_elementwise_fma(sa2, (f32x2){C.bB.z, C.bB.w}, vk3); SB_; } \
        s0 = __builtin_elementwise_fma(s0, (f32x2){C.wA.x, C.wA.y}, t0); SB_; s1 = __builtin_elementwise_fma(s1, (f32x2){C.wA.z, C.wA.w}, t1); SB_; \
        s2 = __builtin_elementwise_fma(s2, (f32x2){C.wB.x, C.wB.y}, t2); SB_; s3 = __builtin_elementwise_fma(s3, (f32x2){C.wB.z, C.wB.w}, t3); SB_; \
        q = s0 * (f32x2){C.rA.x, C.rA.y}; SB_; SC_LD1(L, cA, SB_K, tl); SB_; \
        q = __builtin_elementwise_fma(s1, (f32x2){C.rA.z, C.rA.w}, q); SB_; SC_LD1(L, cB, SB_K + 16, tl); SB_; \
        q = __builtin_elementwise_fma(s2, (f32x2){C.rB.x, C.rB.y}, q); SB_; SC_LD1(L, rA, SB_R, tl); SB_; \
        q = __builtin_elementwise_fma(s3, (f32x2){C.rB.z, C.rB.w}, q); SB_; SC_LD1(L, rB, SB_R + 16, tl); SB_; L.vv = *(const LAS float*)(vrow + (tl) * 256); SB_; \
        qprev = q.x + q.y; SB_; } while (0)
                StepVec V0, V1, V2; SC_LOADV(V0, 0); SC_LOADV(V1, 1); float yk = 0.f, qprev = 0.f;
#pragma unroll
                for (int t = 0; t < 32; ++t) {
                    switch (t % 3) { case 0: SC_STEPF(V0, V2, (t + 2) & 31, (t + 7) & 7); break; case 1: SC_STEPF(V1, V0, (t + 2) & 31, (t + 7) & 7); break; default: SC_STEPF(V2, V1, (t + 2) & 31, (t + 7) & 7); break; }
                    if ((t & 7) == 0 && t > 0) { *(LAS float*)(lds + SC_Y + (c & 1) * 4096 + ((t - 8) + cgp) * 128 + rl * 4) = yk; }
                    SB_; }
                { const float y31 = sum8(qprev); yk = (cgp == 7) ? y31 : yk; *(LAS float*)(lds + SC_Y + (c & 1) * 4096 + (24 + cgp) * 128 + rl * 4) = yk; }
                __syncthreads();
            }
        }
        if (wave >= 4) { const int pc = SEQ / SC_L - 1, ptid = tid - 256; const size_t growp = (size_t)b * SEQ + pc * SC_L; const int t = ptid >> 3, seg = ptid & 7;
            *(f32x4*)(ys + (growp + t) * 512 + 64 * h + 32 * half + 4 * seg) = *(const LAS f32x4*)(lds + SC_Y + (pc & 1) * 4096 + t * 128 + seg * 16); }
        __syncthreads();
    }
}

#define LERP4(cur, prv, m) (f32x4){ bflo(cur.x) + (bflo(prv.x) - bflo(cur.x)) * m.x, bfhi(cur.x) + (bfhi(prv.x) - bfhi(cur.x)) * m.y, bflo(cur.y) + (bflo(prv.y) - bflo(cur.y)) * m.z, bfhi(cur.y) + (bfhi(prv.y) - bfhi(cur.y)) * m.w }
constexpr int PZ_STAT = 0, PZ_ZT = 1024, PZ_WM = PZ_ZT + 128 * 272, PZ_SG = PZ_WM + 128 * 272, PZ_RS = PZ_SG + 128 * 272;
static_assert(PZ_RS + 1024 <= 131072, "post LDS");

__device__ __forceinline__ void post_phase(const Args& a, int li, LAS unsigned char* lds) {
    unsigned char* wsl = a.ws; asm volatile("" : "+s"(wsl));
    int tid_ = threadIdx.x; asm volatile("" : "+v"(tid_)); const int tid = tid_, lane = tid & 63, wave = __builtin_amdgcn_readfirstlane(tid >> 6);
    const bf16* proj = (const bf16*)(wsl + WS_PROJ); const float* ys = (const float*)(wsl + WS_YS); const float* bong = (const float*)(wsl + WS_BON);
    bf16* ycat = (bf16*)(wsl + WS_YCAT);
    const float* mu = a.in[5] + li * P_A; const float* lnx_g = a.in[14] + li * 512; const float* lnx_b = a.in[15] + li * 512;
    const float* bn_g = a.in[16] + li * 512; const float* bn_b = a.in[17] + li * 512; const float* sp_b = a.in[19] + li * 512;
    const bf16* spw = (const bf16*)(wsl + WS_SPW) + (size_t)li * 4 * 128 * 128; const bf16* gupt = (const bf16*)(wsl + WS_GUPT) + (size_t)li * 512 * 128;
    const int n16 = lane & 15, q4 = lane >> 4;
    for (int unit = blockIdx.x; unit < NT / 128; unit += gridDim.x) {
        const size_t t0 = (size_t)unit * 128; const int p0 = (int)(t0 & (SEQ - 1));
        if (tid < 129) { const int pt = p0 + tid - 1; float rsv = 0.f; if (pt >= 0) rsv = rs_from16((const float*)(wsl + WS_SSP) + (t0 + tid - 1) * 16); *(LAS float*)(lds + PZ_RS + tid * 4) = rsv; }
        __syncthreads();
#define PZ_RSL(tl_) (*(const LAS float*)(lds + PZ_RS + ((tl_) + 1) * 4))
#define GELU2(a_, b_, r_) pg8::gelu_pk((pg8::f32x2){(a_) * (r_), (b_) * (r_)})
        { u32x4 zw[16];
#pragma unroll
          for (int r = 0; r < 16; ++r) zw[r] = *(const u32x4*)(proj + (t0 + wave * 16 + r) * P_EVEN + 2304 + 8 * lane);
#pragma unroll
          for (int r = 0; r < 16; ++r) { const int t = wave * 16 + r; const u32x4 w = zw[r];
            const float rt = PZ_RSL(t); const pg8::f32x2 ga = GELU2(bflo(w.x), bfhi(w.x), rt), gb = GELU2(bflo(w.y), bfhi(w.y), rt), gc = GELU2(bflo(w.z), bfhi(w.z), rt), gd = GELU2(bflo(w.w), bfhi(w.w), rt);
            const float x0 = ga.x, x1 = ga.y, x2 = gb.x, x3 = gb.y, x4 = gc.x, x5 = gc.y, x6 = gd.x, x7 = gd.y;
            float s = ((x0 + x1) + (x2 + x3)) + ((x4 + x5) + (x6 + x7)), qq = ((x0 * x0 + x1 * x1) + (x2 * x2 + x3 * x3)) + ((x4 * x4 + x5 * x5) + (x6 * x6 + x7 * x7));
            s = wave_sum(s); qq = wave_sum(qq); const float mean = s * (1.f / 512.f), var = fmaxf(qq * (1.f / 512.f) - mean * mean, 0.f);
            if (lane == 0) *(LAS f32x2*)(lds + PZ_STAT + t * 8) = (f32x2){mean, 1.0f / sqrtf(var + 1e-5f)}; } }
        { const int t = tid >> 2, seg = tid & 3; const bf16* rp = proj + (t0 + t) * P_EVEN + 1664 + 32 * seg; const bool hasprev = (p0 + t) > 0; const float rsT = PZ_RSL(t), rsP = PZ_RSL(t - 1);
#pragma unroll
          for (int v = 0; v < 4; ++v) { const u32x4 cw = *(const u32x4*)(rp + 8 * v); u32x4 pw = {0u, 0u, 0u, 0u}; if (hasprev) pw = *(const u32x4*)(rp - P_EVEN + 8 * v);
              const f32x4 m0 = *(const f32x4*)(mu + 1664 + 32 * seg + 8 * v), m1 = *(const f32x4*)(mu + 1664 + 32 * seg + 8 * v + 4);
              float x[8] = { bflo(cw.x), bfhi(cw.x), bflo(cw.y), bfhi(cw.y), bflo(cw.z), bfhi(cw.z), bflo(cw.w), bfhi(cw.w) };
              const float p[8] = { bflo(pw.x), bfhi(pw.x), bflo(pw.y), bfhi(pw.y), bflo(pw.z), bfhi(pw.z), bflo(pw.w), bfhi(pw.w) };
              const float mm[8] = { m0.x, m0.y, m0.z, m0.w, m1.x, m1.y, m1.z, m1.w };
#pragma unroll
              for (int e = 0; e < 8; ++e) { const float xc = x[e] * rsT, xp = p[e] * rsP; x[e] = sigmoidf_(xc + (xp - xc) * mm[e]); }
              u32x4 o; o.x = pk2(x[0], x[1]); o.y = pk2(x[2], x[3]); o.z = pk2(x[4], x[5]); o.w = pk2(x[6], x[7]);
              *(LAS u32x4*)(lds + PZ_SG + t * 272 + (32 * seg + 8 * v) * 2) = o; } }
        __syncthreads();
        for (int g = 0; g < 4; ++g) {
            { const int cp = tid & 63, tp = tid >> 6; const int c0 = 128 * g + 2 * cp; const float g0 = bn_g[c0], g1 = bn_g[c0 + 1], b0 = bn_b[c0], b1 = bn_b[c0 + 1];
              unsigned wa_[8], wb_[8];
#pragma unroll
              for (int it = 0; it < 8; ++it) { const int tt = tp + 8 * it; wa_[it] = *(const unsigned*)(proj + (t0 + 2 * tt) * P_EVEN + 2304 + c0); wb_[it] = *(const unsigned*)(proj + (t0 + 2 * tt + 1) * P_EVEN + 2304 + c0); }
#pragma unroll
              for (int it = 0; it < 8; ++it) { const int tt = tp + 8 * it; const unsigned wa = wa_[it], wb = wb_[it];
                  const f32x2 sa = *(const LAS f32x2*)(lds + PZ_STAT + (2 * tt) * 8), sb = *(const LAS f32x2*)(lds + PZ_STAT + (2 * tt + 1) * 8);
                  const pg8::f32x2 ya = GELU2(bflo(wa), bfhi(wa), PZ_RSL(2 * tt)), yb = GELU2(bflo(wb), bfhi(wb), PZ_RSL(2 * tt + 1));
                  const float za0 = (ya.x - sa.x) * sa.y * g0 + b0, za1 = (ya.y - sa.x) * sa.y * g1 + b1, zb0 = (yb.x - sb.x) * sb.y * g0 + b0, zb1 = (yb.y - sb.x) * sb.y * g1 + b1;
                  *(LAS unsigned*)(lds + PZ_ZT + (2 * cp) * 272 + (2 * tt) * 2) = pk2(za0, zb0); *(LAS unsigned*)(lds + PZ_ZT + (2 * cp + 1) * 272 + (2 * tt) * 2) = pk2(za1, zb1); } }
            { const int i = tid >> 2, seg = tid & 3; const bf16* src = spw + (size_t)(g * 128 + i) * 128 + 32 * seg;
#pragma unroll
              for (int v = 0; v < 4; ++v) *(LAS u32x4*)(lds + PZ_WM + i * 272 + (32 * seg + 8 * v) * 2) = *(const u32x4*)(src + 8 * v); }
            __syncthreads();
            { const int db = wave; bf16x8 Af[4];
#pragma unroll
              for (int kk = 0; kk < 4; ++kk) Af[kk] = *(const LAS bf16x8*)(lds + PZ_ZT + (16 * db + n16) * 272 + (32 * kk + 8 * q4) * 2);
              for (int ib = 0; ib < 8; ++ib) { f32x4 acc = {0.f, 0.f, 0.f, 0.f};
#pragma unroll
                  for (int kk = 0; kk < 4; ++kk) if (32 * kk <= 16 * ib + 15) { const bf16x8 Bf = *(const LAS bf16x8*)(lds + PZ_WM + (16 * ib + n16) * 272 + (32 * kk + 8 * q4) * 2);
                      acc = __builtin_amdgcn_mfma_f32_16x16x32_bf16(Af[kk], Bf, acc, 0, 0, 0); }
                  const int i = 16 * ib + n16, c = 128 * g + 16 * db + 4 * q4; const float bias = sp_b[g * 128 + i];
                  const u32x2 uw = *(const u32x2*)(proj + (t0 + i) * P_EVEN + 1792 + c);
                  const float ri = PZ_RSL(i); const pg8::f32x2 u01 = GELU2(bflo(uw.x), bfhi(uw.x), ri), u23 = GELU2(bflo(uw.y), bfhi(uw.y), ri);
                  u32x2 o; o.x = pk2(u01.x * (acc[0] + bias), u01.y * (acc[1] + bias)); o.y = pk2(u23.x * (acc[2] + bias), u23.y * (acc[3] + bias));
                  *(u32x2*)(ycat + (t0 + i) * DM + 512 + c) = o; } }
            __syncthreads();
        }
        { const int h = wave; bf16x8 Ag[4][4];
#pragma unroll
          for (int cb = 0; cb < 4; ++cb)
#pragma unroll
              for (int kk = 0; kk < 4; ++kk) Ag[cb][kk] = *(const bf16x8*)(gupt + (size_t)(64 * h + 16 * cb + n16) * 128 + 32 * kk + 8 * q4);
          for (int tb = 0; tb < 8; ++tb) {
              f32x4 G[4];
#pragma unroll
              for (int cb = 0; cb < 4; ++cb) G[cb] = (f32x4){0.f, 0.f, 0.f, 0.f};
#pragma unroll
              for (int kk = 0; kk < 4; ++kk) { const bf16x8 Bf = *(const LAS bf16x8*)(lds + PZ_SG + (16 * tb + n16) * 272 + (32 * kk + 8 * q4) * 2);
#pragma unroll
                  for (int cb = 0; cb < 4; ++cb) G[cb] = __builtin_amdgcn_mfma_f32_16x16x32_bf16(Ag[cb][kk], Bf, G[cb], 0, 0, 0); }
              const int tl = 16 * tb + n16; const size_t tt = t0 + tl; const bool hasprev = (p0 + tl) > 0;
              f32x4 y[4]; float s = 0.f;
#pragma unroll
              for (int cb = 0; cb < 4; ++cb) { y[cb] = *(const f32x4*)(ys + tt * 512 + 64 * h + 16 * cb + 4 * q4); s += (y[cb].x + y[cb].y) + (y[cb].z + y[cb].w); }
              s += shx(s, lane, 16); s += shx(s, lane, 32); const float mean = s * (1.f / 64.f); float qq = 0.f;
#pragma unroll
              for (int cb = 0; cb < 4; ++cb) { y[cb] = y[cb] - mean; qq += (y[cb].x * y[cb].x + y[cb].y * y[cb].y) + (y[cb].z * y[cb].z + y[cb].w * y[cb].w); }
              qq += shx(qq, lane, 16); qq += shx(qq, lane, 32); const float rstd = 1.0f / sqrtf(qq * (1.f / 64.f) + 64e-5f);
              const float bon = bong[tt * 8 + h];
#pragma unroll
              for (int cb = 0; cb < 4; ++cb) { const int c = 64 * h + 16 * cb + 4 * q4;
                  const u32x2 cv = *(const u32x2*)(proj + tt * P_EVEN + 1024 + c); u32x2 pv = {0u, 0u}; if (hasprev) pv = *(const u32x2*)(proj + (tt - 1) * P_EVEN + 1024 + c);
                  const f32x4 m = *(const f32x4*)(mu + 1024 + c), lg = *(const f32x4*)(lnx_g + c), lb = *(const f32x4*)(lnx_b + c);
                  const float rT = PZ_RSL(tl), rP = PZ_RSL(tl - 1);
                  const f32x4 vc = (f32x4){bflo(cv.x), bfhi(cv.x), bflo(cv.y), bfhi(cv.y)} * rT, vp = (f32x4){bflo(pv.x), bfhi(pv.x), bflo(pv.y), bfhi(pv.y)} * rP; const f32x4 v4 = vc + (vp - vc) * m;
                  const f32x4 o = ((y[cb] * rstd) * lg + lb + v4 * bon) * G[cb];
                  u32x2 w; w.x = pk2(o.x, o.y); w.y = pk2(o.z, o.w); *(u32x2*)(ycat + tt * DM + c) = w; }
          } }
        __syncthreads();
    }
}

constexpr int OM_GL = 0, OM_CV = 62 * 1024, OM_RS = OM_CV + 32 * 2048;
static_assert(OM_RS + 256 <= 131072, "odd LDS");
template <int WIN> __device__ __forceinline__ void pool_rows(const bf16* proj, bf16* ycat, size_t t0, int p0, int c, const LAS float* rsl  ) {
    float x[47];
#pragma unroll
    for (int i = 0; i < 47; ++i) { const int p = p0 - 15 + i; x[i] = (i >= 16 - WIN) ? ((p >= 0) ? bf1(proj[(t0 - 15 + i) * P_ODD + 1024 + c]) * rsl[15 + i] : 0.f) : 0.f; }
#pragma unroll
    for (int t = 0; t < 32; ++t) { float s = 0.f;
#pragma unroll
        for (int k = 0; k < WIN; ++k) s += x[15 + t - k];
        const int p = p0 + t; const float cnt = (float)((p + 1 < WIN) ? p + 1 : WIN);
        ycat[(t0 + t) * DM + 512 + c] = (bf16)f2bf(s / cnt - x[15 + t]); }
}
__device__ __forceinline__ void oddmix_phase(const Args& a, int li, LAS unsigned char* lds) {
    unsigned char* wsl = a.ws; asm volatile("" : "+s"(wsl));
    int tid_ = threadIdx.x; asm volatile("" : "+v"(tid_)); const int tid = tid_, lane = tid & 63, wave = __builtin_amdgcn_readfirstlane(tid >> 6);
    const bf16* proj = (const bf16*)(wsl + WS_PROJ); bf16* ycat = (bf16*)(wsl + WS_YCAT);
    const float* conv_w = a.in[22] + li * 31 * 512; const float* conv_b = a.in[23] + li * 512; const float* cn_g = a.in[24] + li * 512; const float* cn_b = a.in[25] + li * 512;
    float cw[31];
#pragma unroll
    for (int k = 0; k < 31; ++k) cw[k] = conv_w[k * 512 + tid];
    const float cb = conv_b[tid];
    f32x4 g0 = *(const f32x4*)(cn_g + 8 * lane), g1 = *(const f32x4*)(cn_g + 8 * lane + 4), b0 = *(const f32x4*)(cn_b + 8 * lane), b1 = *(const f32x4*)(cn_b + 8 * lane + 4);
    for (int unit = blockIdx.x; unit < NT / 32; unit += gridDim.x) {
        const size_t t0 = (size_t)unit * 32; const int p0 = (int)(t0 & (SEQ - 1));
        if (tid < 62) { const int pt = p0 - 30 + tid; float rsv = 0.f; if (pt >= 0) rsv = rs_from16((const float*)(wsl + WS_SSP) + (t0 + tid - 30) * 16); *(LAS float*)(lds + OM_RS + tid * 4) = rsv; }
        __syncthreads();
        { u32x4 gv_[8], gg_[8];
#pragma unroll
          for (int it = 0; it < 8; ++it) { const int task = tid + it * NTHREADS; const int rr = task >> 6, seg = task & 63; const int p = p0 - 30 + rr; gv_[it] = (u32x4){0u, 0u, 0u, 0u}; gg_[it] = (u32x4){0u, 0u, 0u, 0u};
              if (task < 62 * 64 && p >= 0) { const bf16* rp = proj + (t0 + rr - 30) * P_ODD + 8 * seg; gv_[it] = *(const u32x4*)rp; gg_[it] = *(const u32x4*)(rp + 512); } }
#pragma unroll
          for (int it = 0; it < 8; ++it) { const int task = tid + it * NTHREADS; const int rr = task >> 6, seg = task & 63; const u32x4 v = gv_[it], gt = gg_[it]; u32x4 o; const float rr_s = (task < 62 * 64) ? *(const LAS float*)(lds + OM_RS + rr * 4) : 0.f;
#define GLU1(a_, b_) ((a_) * rr_s * sigmoidf_((b_) * rr_s))
              o.x = pk2(GLU1(bflo(v.x), bflo(gt.x)), GLU1(bfhi(v.x), bfhi(gt.x))); o.y = pk2(GLU1(bflo(v.y), bflo(gt.y)), GLU1(bfhi(v.y), bfhi(gt.y)));
              o.z = pk2(GLU1(bflo(v.z), bflo(gt.z)), GLU1(bfhi(v.z), bfhi(gt.z))); o.w = pk2(GLU1(bflo(v.w), bflo(gt.w)), GLU1(bfhi(v.w), bfhi(gt.w)));
              if (task < 62 * 64) *(LAS u32x4*)(lds + OM_GL + rr * 1024 + seg * 16) = o; } }
        __syncthreads();
#pragma unroll 1
        for (int ob = 0; ob < 4; ++ob) { float xin[38];
#pragma unroll
            for (int i = 0; i < 38; ++i) xin[i] = bf1(*(const LAS bf16*)(lds + OM_GL + (ob * 8 + i) * 1024 + tid * 2));
#pragma unroll
            for (int t = 0; t < 8; ++t) { float acc = cb;
#pragma unroll
                for (int k = 0; k < 31; ++k) acc += cw[k] * xin[t + k];
                *(LAS float*)(lds + OM_CV + (ob * 8 + t) * 2048 + tid * 4) = acc; } }
        __syncthreads();
#pragma unroll 1
        for (int r = 0; r < 4; ++r) { const int t = wave * 4 + r; f32x4 v0 = *(const LAS f32x4*)(lds + OM_CV + t * 2048 + lane * 32), v1 = *(const LAS f32x4*)(lds + OM_CV + t * 2048 + lane * 32 + 16);
            float s = ((v0.x + v0.y) + (v0.z + v0.w)) + ((v1.x + v1.y) + (v1.z + v1.w)); s = wave_sum(s); const float mean = s * (1.f / 512.f);
            v0 = v0 - mean; v1 = v1 - mean; float qq = ((v0.x * v0.x + v0.y * v0.y) + (v0.z * v0.z + v0.w * v0.w)) + ((v1.x * v1.x + v1.y * v1.y) + (v1.z * v1.z + v1.w * v1.w));
            qq = wave_sum(qq); const float rstd = 1.0f / sqrtf(qq * (1.f / 512.f) + 1e-5f);
            v0 = v0 * rstd * g0 + b0; v1 = v1 * rstd * g1 + b1;
            u32x4 o; o.x = pk2(v0.x * sigmoidf_(v0.x), v0.y * sigmoidf_(v0.y)); o.y = pk2(v0.z * sigmoidf_(v0.z), v0.w * sigmoidf_(v0.w));
            o.z = pk2(v1.x * sigmoidf_(v1.x), v1.y * sigmoidf_(v1.y)); o.w = pk2(v1.z * sigmoidf_(v1.z), v1.w * sigmoidf_(v1.w));
            *(u32x4*)(ycat + (t0 + t) * DM + 8 * lane) = o; }
        { const int gi = wave >> 1;
          const LAS float* rsl = (const LAS float*)(lds + OM_RS);
          if (gi == 0) pool_rows<2>(proj, ycat, t0, p0, tid, rsl); else if (gi == 1) pool_rows<4>(proj, ycat, t0, p0, tid, rsl); else if (gi == 2) pool_rows<8>(proj, ycat, t0, p0, tid, rsl); else pool_rows<16>(proj, ycat, t0, p0, tid, rsl); }
        __syncthreads();
    }
    __syncthreads();
}

#define REPEAT(n) _Pragma("unroll 1") for (int rep_ = 0; rep_ < (n); ++rep_)
#define REP_SYNC 1
#define REP_PREP 1
typedef __attribute__((address_space(1))) unsigned gu32;
#define XB_TMO      128
#define XB_XCNT(j)  (256  + 64 * (j))
#define XB_XSUB(j)  (1280 + 64 * (j))
#define XB_XGEN(j)  (2304 + 64 * (j))
#define XB_TOP      3328
#define XB_TOPGEN   3392
#define XCD_BAR_WORDS 3456
#define XB_SPIN_CAP (1u << 18)

__device__ __forceinline__ unsigned xb_ld(unsigned* p)              { return __hip_atomic_load(p, __ATOMIC_RELAXED, __HIP_MEMORY_SCOPE_AGENT); }
__device__ __forceinline__ unsigned xb_add(unsigned* p, unsigned v) { return __hip_atomic_fetch_add(p, v, __ATOMIC_RELAXED, __HIP_MEMORY_SCOPE_AGENT); }
__device__ __forceinline__ unsigned xb_xcc_id() { return (unsigned)__builtin_amdgcn_s_getreg((3 << 11) | 20) & 0xFu; }
#define XB_SPIN(cond, bar) do { unsigned _sp = 0; while (cond) { __builtin_amdgcn_s_sleep(1); \
    if ((++_sp & 255u) == 0u) { if (xb_ld(&(bar)[XB_TMO])) break; if (_sp > XB_SPIN_CAP) { atomicAdd(&(bar)[XB_TMO], 1u); break; } } } } while (0)

struct XcdBarrier {
    unsigned* bar; unsigned x;
    volatile LAS unsigned* st;
};

__device__ __forceinline__ XcdBarrier xcd_barrier_post(unsigned* bar, volatile LAS unsigned* st) {
    XcdBarrier b; b.bar = bar; b.x = xb_xcc_id(); b.st = st;
    if (threadIdx.x == 0) (void)xb_add(&bar[XB_XCNT(b.x)], 1u);
    return b;
}
__device__ __forceinline__ void xcd_barrier_complete(unsigned* bar, unsigned x, unsigned& nloc, unsigned& nx) {
    const unsigned G = gridDim.x * gridDim.y * gridDim.z;
    unsigned sum, cnt, mine, sp = 0u;
    for (;;) {
        sum = 0u; cnt = 0u; mine = 0u;
#pragma unroll
        for (unsigned j = 0; j < 16; ++j) { const unsigned c = xb_ld(&bar[XB_XCNT(j)]); sum += c; cnt += (c > 0u) ? 1u : 0u; mine = (j == x) ? c : mine; }
        if (sum == G) break;
        __builtin_amdgcn_s_sleep(1);
        if ((++sp & 255u) == 0u) { if (xb_ld(&bar[XB_TMO])) break; if (sp > XB_SPIN_CAP) { atomicAdd(&bar[XB_TMO], 1u); break; } }
    }
    nloc = mine > 0u ? mine : 1u; nx = cnt > 0u ? cnt : 1u;
}

__device__ __forceinline__ void xcd_barrier(const XcdBarrier& b) {
    asm volatile("s_waitcnt vmcnt(0)" ::: "memory");
    __syncthreads();
    if (threadIdx.x == 0) {
        unsigned* bar = b.bar;
        __builtin_amdgcn_s_waitcnt(0);
        unsigned nloc = b.st[0], nx = b.st[1];
        if (nloc == 0u) { xcd_barrier_complete(bar, b.x, nloc, nx); b.st[0] = nloc; b.st[1] = nx; }
        const unsigned old = xb_add(&bar[XB_XSUB(b.x)], 1u);
        const unsigned gen = old / nloc;
        if (old + 1u == (gen + 1u) * nloc) {
            __builtin_amdgcn_fence(__ATOMIC_RELEASE, "agent");
            asm volatile("s_waitcnt vmcnt(0)" ::: "memory");
            const unsigned og = xb_add(&bar[XB_TOP], 1u);
            const unsigned tg = og / nx;
            if (og + 1u == (tg + 1u) * nx) xb_add(&bar[XB_TOPGEN], 1u);
            else XB_SPIN(xb_ld(&bar[XB_TOPGEN]) == tg, bar);
            __builtin_amdgcn_fence(__ATOMIC_ACQUIRE, "agent");
            xb_add(&bar[XB_XGEN(b.x)], 1u);
            asm volatile("s_waitcnt vmcnt(0)" ::: "memory");
        } else {
            XB_SPIN(xb_ld(&bar[XB_XGEN(b.x)]) == gen, bar);
            __builtin_amdgcn_fence(__ATOMIC_ACQUIRE, "agent");
            asm volatile("s_waitcnt vmcnt(0)" ::: "memory");
        }
    }
    __syncthreads();
}

#define GSYNC() do { _Pragma("unroll 1") for (int rs_ = 0; rs_ < REP_SYNC; ++rs_) xcd_barrier(xbar); } while (0)
#define REP_NORM 1
#define REP_G1 1
#define REP_SCAN 1
#define REP_POST 1
#define REP_ODD 1
#define REP_G3 1
__global__ void __launch_bounds__(NTHREADS, 2) trunk_fwd(Args args) {
    extern __shared__ __attribute__((aligned(16))) unsigned char lds_raw[];
    LAS unsigned char* lds = (LAS unsigned char*)lds_raw;
    cg::grid_group grid = cg::this_grid();
    unsigned char* ws = args.ws; const int G = gridDim.x;
    bf16* HN = (bf16*)(ws + WS_HN); bf16* PROJ = (bf16*)(ws + WS_PROJ); bf16* YCAT = (bf16*)(ws + WS_YCAT); bf16* HB = (bf16*)(ws + WS_H);
    if (threadIdx.x < 16) ((LAS unsigned*)(lds + XB_LDS_OFF))[threadIdx.x] = 0u;
    __syncthreads();
    const XcdBarrier xbar = xcd_barrier_post((unsigned*)(ws + WS_CTL), (volatile LAS unsigned*)(lds + XB_LDS_OFF));
    REPEAT(REP_PREP) { prep_phase(args, lds); }
    rmsnorm_phase(args.in[0], nullptr, args.in[1], (bf16*)(ws + WS_SSP), HB);
    if (args.out == nullptr) grid.sync();
    GSYNC();
#pragma unroll 1
    for (int layer = 0; layer < DEPTH; ++layer) {
        const int li = layer >> 1; const bool even = (layer & 1) == 0;
        const float* hin = (layer == 0) ? args.in[0] : nullptr;
        asm volatile("" : "+s"(HN), "+s"(PROJ), "+s"(YCAT), "+s"(ws), "+s"(hin), "+s"(HB));
        if (even) {
            REPEAT(REP_G1) { pg8::Gemm g{HB, (const bf16*)(ws + WS_EVIN) + (size_t)li * P_EVEN * DM, NT, P_EVEN, DM}; pg8::StaticOrder S; S.init(NT, P_EVEN, G, (int)blockIdx.x);
              pg8::EpiProj E{PROJ, P_EVEN, 1000}; pg8::gemm_phase<pg8::EpiProj, pg8::StaticOrder, true, true>(lds, g, S, E);
            GSYNC(); }
            REPEAT(REP_SCAN) { scan_phase(args, li, lds);
            GSYNC(); }
            REPEAT(REP_POST) { post_phase(args, li, lds);
            GSYNC(); }
        } else {
            REPEAT(REP_G1) { pg8::Gemm g{HB, (const bf16*)(ws + WS_ODIN) + (size_t)li * P_ODD * DM, NT, P_ODD, DM}; pg8::StaticOrder S; S.init(NT, P_ODD, G, (int)blockIdx.x);
              pg8::EpiProj E{PROJ, P_ODD, 1000}; pg8::gemm_phase<pg8::EpiProj, pg8::StaticOrder, true, true>(lds, g, S, E);
            GSYNC(); }
            REPEAT(REP_ODD) { oddmix_phase(args, li, lds);
            GSYNC(); }
        }
        { pg8::Gemm g{YCAT, (const bf16*)(ws + WS_WOUT) + (size_t)layer * DM * DM, NT, DM, DM}; pg8::StaticOrder S; S.init(NT, DM, G, (int)blockIdx.x);
          unsigned* xb = (unsigned*)(ws + WS_XB); unsigned* pc = (unsigned*)(ws + WS_CNT); const float* gn = args.in[2] + layer * DM; const unsigned tg = 16u * (unsigned)(layer + 1);
          { pg8::EpiResX<false, false> E{nullptr, HB, HB, HN, nullptr, gn, DM, xb, pc, tg, lds}; pg8::gemm_phase<pg8::EpiResX<false, false>, pg8::StaticOrder, true, true>(lds, g, S, E); } }
        GSYNC();
        REPEAT(REP_G3) { pg8::Gemm g{HN, (const bf16*)(ws + WS_GU) + (size_t)layer * 2 * FF * DM, NT, 2 * FF, DM}; pg8::StaticOrder S; S.init(NT, 2 * FF, G, (int)blockIdx.x);
          pg8::EpiSwiGLU E{PROJ, FF}; pg8::gemm_phase<pg8::EpiSwiGLU, pg8::StaticOrder, true, true>(lds, g, S, E);
        GSYNC(); }
        { pg8::Gemm g{PROJ, (const bf16*)(ws + WS_DN) + (size_t)layer * DM * FF, NT, DM, FF}; pg8::StaticOrder S; S.init(NT, DM, G, (int)blockIdx.x);
          unsigned* xb = (unsigned*)(ws + WS_XB); unsigned* pc = (unsigned*)(ws + WS_CNT); const unsigned tg = 16u * (unsigned)(DEPTH + 1);
          if (layer == DEPTH - 1) { pg8::EpiResX<false, true> E{nullptr, HB, nullptr, nullptr, args.out, args.in[3], DM, xb, pc, tg, lds}; pg8::gemm_phase<pg8::EpiResX<false, true>, pg8::StaticOrder, true, true>(lds, g, S, E); }
          else { pg8::EpiResT<false> E{nullptr, HB, HB, DM, (float*)(ws + WS_SSP)}; pg8::gemm_phase<pg8::EpiResT<false>, pg8::StaticOrder, true, true>(lds, g, S, E); } }
        GSYNC();
    }
}

extern "C" void kernel_launch(void* const* d_in, const int* in_sizes, int n_in, void* d_out, int out_size, void* d_ws, size_t ws_size, hipStream_t stream) {
    static int grid = 0;
    if (grid == 0) {
        if (n_in != 32 || out_size != NT * DM || ws_size < WS_END) { fprintf(stderr, "kernel_launch: unexpected shapes (n_in %d out %d ws %zu)\n", n_in, out_size, ws_size); grid = -1; return; }
        int dev = 0, cus = 0, per_cu = 0;
        hipGetDevice(&dev); hipDeviceGetAttribute(&cus, hipDeviceAttributeMultiprocessorCount, dev);
        if (hipFuncSetAttribute((const void*)trunk_fwd, hipFuncAttributeMaxDynamicSharedMemorySize, LDS_BYTES) != hipSuccess) { fprintf(stderr, "kernel_launch: hipFuncSetAttribute failed\n"); grid = -1; return; }
        if (hipOccupancyMaxActiveBlocksPerMultiprocessor(&per_cu, (const void*)trunk_fwd, NTHREADS, LDS_BYTES) != hipSuccess || per_cu < 1) { fprintf(stderr, "kernel_launch: occupancy query says %d\n", per_cu); per_cu = 1; }
        (void)hipGetLastError();
        grid = cus * 1;
    }
    if (grid < 0) return;
    if (hipMemsetAsync((char*)d_ws + WS_CTL, 0, 131072, stream) != hipSuccess) { fprintf(stderr, "kernel_launch: memset of the control words failed\n"); return; }
    Args a{};
    for (int i = 0; i < 32; ++i) a.in[i] = (const float*)d_in[i];
    a.out = (float*)d_out; a.ws = (unsigned char*)d_ws;
    void* kargs[] = { &a };
    hipError_t e = hipLaunchCooperativeKernel((const void*)trunk_fwd, dim3(grid), dim3(NTHREADS), kargs, LDS_BYTES, stream);
    if (e != hipSuccess) fprintf(stderr, "cooperative launch failed: %s (grid %d)\n", hipGetErrorString(e), grid);
}
```

```cpp
#include <hip/hip_runtime.h>
#include <hip/hip_cooperative_groups.h>
#include <cstdio>
#include <cstdint>
namespace pg8 {
#define PG8_LAS __attribute__((address_space(3)))
typedef unsigned short bf16_t;
typedef short bf16x8 __attribute__((ext_vector_type(8)));
typedef float f32x4 __attribute__((ext_vector_type(4)));
typedef unsigned u32x4 __attribute__((ext_vector_type(4)));
constexpr int BM = 256, BK = 64, HALF = 128, HTB = HALF * BK * 2  , STAGE_BYTES = 8 * HTB, NXCD = 8, WGM = 8;

__host__ __device__ __forceinline__ int lds_byte(int r, int c) { const int st = (r >> 4) * 2 + (c >> 5), rr = r & 15, cc = c & 31, ob = rr * 64 + cc * 2; return st * 1024 + (ob ^ (((ob >> 9) & 1) << 5)); }
__host__ __device__ __forceinline__ void stage_rc(int b, int& R, int& C) { const int st = b / 1024, sb = b % 1024, swz = sb ^ (((sb >> 9) & 1) << 5); R = (st >> 1) * 16 + swz / 64; C = (st & 1) * 32 + (swz % 64) / 2; }
__host__ __device__ __forceinline__ int perm32(int rho) { const int n = rho >> 4, i = rho & 15; return 8 * (i >> 2) + 4 * n + (i & 3); }

struct Unit { int pm, pn; };
struct Gemm { const bf16_t* A; const bf16_t* Bt; int M, N, K; };

struct StaticOrder {
    int nM, nN, nwg, G, c;
    __host__ __device__ void init(int M, int N, int G_, int c_) { nM = M / BM; nN = N / BM; nwg = nM * nN; G = G_; c = c_; }
    __host__ __device__ bool next(int i, Unit& u) const {
        const long L = (long)i * G + c; if (L >= nwg) return false;
        int wgid = (int)L; { const int q = nwg / NXCD, r = nwg % NXCD, xcd = wgid % NXCD, off = wgid / NXCD; wgid = (xcd < r ? xcd * (q + 1) : r * (q + 1) + (xcd - r) * q) + off; }
        const int nig = WGM * nN, gid = wgid / nig, fm = gid * WGM, gsz = (nM - fm) < WGM ? (nM - fm) : WGM;
        u.pm = fm + ((wgid % nig) % gsz); u.pn = (wgid % nig) / gsz; return true;
    }
    __device__ __forceinline__ void a_ready(const Unit&) const {}
    __device__ __forceinline__ void done(const Unit&) const {}
};

__device__ __forceinline__ unsigned cvt_pk_bf16(float lo, float hi) { unsigned r; asm volatile("v_cvt_pk_bf16_f32 %0, %1, %2" : "=v"(r) : "v"(lo), "v"(hi)); return r; }
typedef float f32x2 __attribute__((ext_vector_type(2)));
__device__ __forceinline__ f32x2 gelu_pk(f32x2 v) {
    const f32x2 av = __builtin_elementwise_abs(v), d = av * 0.2316418882f + 1.0f;
    f32x2 t; t.x = __builtin_amdgcn_rcpf(d.x); t.y = __builtin_amdgcn_rcpf(d.y);
    f32x2 q = t * 0.5307027145f + (-0.7265760135f); q = q * t + 0.7107068705f; q = q * t + (-0.142248368f); q = q * t + 0.127414796f; q = q * t;
    const f32x2 s = (v * v) * (-0.72134752044f);
    f32x2 e; e.x = __builtin_amdgcn_exp2f(s.x); e.y = __builtin_amdgcn_exp2f(s.y);
    const f32x2 m = v * (q * e), r = v - m;
    f32x2 o; o.x = v.x < 0.f ? m.x : r.x; o.y = v.y < 0.f ? m.y : r.y; return o;
}

struct EpiProj {
    static constexpr bool PERM = true, AFTER_DRAIN = false;
    bf16_t* O; int ldc; int gelu_from;
    __device__ __forceinline__ void operator()(const f32x4 (&acc)[2][2][4][2], const Unit& u, int wr, int wc, int fr, int fq) const {
        const int row0 = u.pm * BM + wr * 64 + fr; const int col0 = u.pn * BM + wc * 32 + 8 * fq; const bool act = u.pn >= gelu_from;
#pragma unroll
        for (int ai = 0; ai < 2; ++ai)
#pragma unroll
            for (int m = 0; m < 4; ++m) { bf16_t* rowp = O + (size_t)(row0 + ai * HALF + m * 16) * ldc + col0;
#pragma unroll
                for (int bj = 0; bj < 2; ++bj) { f32x4 v0 = acc[ai][bj][m][0], v1 = acc[ai][bj][m][1];
                    if (act) { f32x2 a = gelu_pk((f32x2){v0[0], v0[1]}), b = gelu_pk((f32x2){v0[2], v0[3]}), c = gelu_pk((f32x2){v1[0], v1[1]}), d = gelu_pk((f32x2){v1[2], v1[3]});
                        v0 = (f32x4){a.x, a.y, b.x, b.y}; v1 = (f32x4){c.x, c.y, d.x, d.y}; }
                    u32x4 w; w.x = cvt_pk_bf16(v0[0], v0[1]); w.y = cvt_pk_bf16(v0[2], v0[3]); w.z = cvt_pk_bf16(v1[0], v1[1]); w.w = cvt_pk_bf16(v1[2], v1[3]);
                    *(u32x4*)(rowp + bj * HALF) = w; } }
    }
};
template <bool BASE_F32> struct EpiResT {
    static constexpr bool PERM = true, AFTER_DRAIN = false;
    const float* basef; const bf16_t* baseh; bf16_t* hout; int ldc;
    __device__ __forceinline__ void operator()(const f32x4 (&acc)[2][2][4][2], const Unit& u, int wr, int wc, int fr, int fq) const {
        const int row0 = u.pm * BM + wr * 64 + fr, col0 = u.pn * BM + wc * 32 + 8 * fq;
#pragma unroll
        for (int ai = 0; ai < 2; ++ai)
#pragma unroll
            for (int mp = 0; mp < 2; ++mp) {
                if constexpr (BASE_F32) {
                    f32x4 bs[2][2][2];
#pragma unroll
                    for (int mm = 0; mm < 2; ++mm)
#pragma unroll
                        for (int bj = 0; bj < 2; ++bj)
#pragma unroll
                            for (int n = 0; n < 2; ++n) bs[mm][bj][n] = *(const f32x4*)(basef + (size_t)(row0 + ai * HALF + (2 * mp + mm) * 16) * ldc + col0 + bj * HALF + n * 4);
#pragma unroll
                    for (int mm = 0; mm < 2; ++mm)
#pragma unroll
                        for (int bj = 0; bj < 2; ++bj) { const int m = 2 * mp + mm; const f32x4 h0 = bs[mm][bj][0] + acc[ai][bj][m][0], h1 = bs[mm][bj][1] + acc[ai][bj][m][1];
                            u32x4 w; w.x = cvt_pk_bf16(h0[0], h0[1]); w.y = cvt_pk_bf16(h0[2], h0[3]); w.z = cvt_pk_bf16(h1[0], h1[1]); w.w = cvt_pk_bf16(h1[2], h1[3]);
                            *(u32x4*)(hout + (size_t)(row0 + ai * HALF + m * 16) * ldc + col0 + bj * HALF) = w; }
                } else {
                    u32x4 bs[2][2];
#pragma unroll
                    for (int mm = 0; mm < 2; ++mm)
#pragma unroll
                        for (int bj = 0; bj < 2; ++bj) bs[mm][bj] = *(const u32x4*)(baseh + (size_t)(row0 + ai * HALF + (2 * mp + mm) * 16) * ldc + col0 + bj * HALF);
#pragma unroll
                    for (int mm = 0; mm < 2; ++mm)
#pragma unroll
                        for (int bj = 0; bj < 2; ++bj) { const int m = 2 * mp + mm; const u32x4 q = bs[mm][bj]; const f32x4 a0 = acc[ai][bj][m][0], a1 = acc[ai][bj][m][1];
                            u32x4 w;
                            w.x = cvt_pk_bf16(__builtin_bit_cast(float, q.x << 16) + a0[0], __builtin_bit_cast(float, q.x & 0xffff0000u) + a0[1]);
                            w.y = cvt_pk_bf16(__builtin_bit_cast(float, q.y << 16) + a0[2], __builtin_bit_cast(float, q.y & 0xffff0000u) + a0[3]);
                            w.z = cvt_pk_bf16(__builtin_bit_cast(float, q.z << 16) + a1[0], __builtin_bit_cast(float, q.z & 0xffff0000u) + a1[1]);
                            w.w = cvt_pk_bf16(__builtin_bit_cast(float, q.w << 16) + a1[2], __builtin_bit_cast(float, q.w & 0xffff0000u) + a1[3]);
                            *(u32x4*)(hout + (size_t)(row0 + ai * HALF + m * 16) * ldc + col0 + bj * HALF) = w; }
                }
                asm volatile("" ::: "memory"); }
    }
};
template <bool BASE_F32, bool FINAL> struct EpiResX {
    static constexpr bool PERM = true, AFTER_DRAIN = false;
    const float* basef; const bf16_t* baseh; bf16_t* hout; bf16_t* hn; float* outf; const float* gain; int ldc;
    unsigned* xbuf; unsigned* cnt; unsigned target; PG8_LAS unsigned char* lds;
    __device__ __forceinline__ void operator()(f32x4 (&acc)[2][2][4][2], const Unit& u, int wr, int wc, int fr_, int fq_) const {
        int fr = fr_, fq = fq_; asm volatile("" : "+v"(fr), "+v"(fq));
        const int lane = fq * 16 + fr, wid = wr * 4 + wc, tid = wid * 64 + lane;
        PG8_LAS float* P = (PG8_LAS float*)(lds + 131072); PG8_LAS float* S = (PG8_LAS float*)(lds + 131072 + 4096);
        const int row0 = u.pm * BM + wr * 64 + fr, col0 = u.pn * BM + wc * 32 + 8 * fq;
        if constexpr (BASE_F32) {
#pragma unroll
            for (int ai = 0; ai < 2; ++ai)
#pragma unroll
                for (int mp = 0; mp < 2; ++mp) { f32x4 bsf[2][2][2];
#pragma unroll
                    for (int mm = 0; mm < 2; ++mm)
#pragma unroll
                        for (int bj = 0; bj < 2; ++bj) { const size_t off = (size_t)(row0 + ai * HALF + (2 * mp + mm) * 16) * ldc + col0 + bj * HALF; bsf[mm][bj][0] = *(const f32x4*)(basef + off); bsf[mm][bj][1] = *(const f32x4*)(basef + off + 4); }
#pragma unroll
                    for (int mm = 0; mm < 2; ++mm)
#pragma unroll
                        for (int bj = 0; bj < 2; ++bj) { const int m = 2 * mp + mm; acc[ai][bj][m][0] += bsf[mm][bj][0]; acc[ai][bj][m][1] += bsf[mm][bj][1]; }
                    asm volatile("" ::: "memory"); }
        } else {
#pragma unroll
            for (int ai = 0; ai < 2; ++ai) { u32x4 bsh[4][2];
#pragma unroll
                for (int m = 0; m < 4; ++m)
#pragma unroll
                    for (int bj = 0; bj < 2; ++bj) bsh[m][bj] = *(const u32x4*)(baseh + (size_t)(row0 + ai * HALF + m * 16) * ldc + col0 + bj * HALF);
#pragma unroll
                for (int m = 0; m < 4; ++m)
#pragma unroll
                    for (int bj = 0; bj < 2; ++bj) { const u32x4 q = bsh[m][bj];
                        acc[ai][bj][m][0] += (f32x4){__builtin_bit_cast(float, q.x << 16), __builtin_bit_cast(float, q.x & 0xffff0000u), __builtin_bit_cast(float, q.y << 16), __builtin_bit_cast(float, q.y & 0xffff0000u)};
                        acc[ai][bj][m][1] += (f32x4){__builtin_bit_cast(float, q.z << 16), __builtin_bit_cast(float, q.z & 0xffff0000u), __builtin_bit_cast(float, q.w << 16), __builtin_bit_cast(float, q.w & 0xffff0000u)}; }
                asm volatile("" ::: "memory"); }
        }
#pragma unroll
        for (int ai = 0; ai < 2; ++ai)
#pragma unroll
            for (int m = 0; m < 4; ++m) { float ss = 0.f;
#pragma unroll
                for (int bj = 0; bj < 2; ++bj) { const f32x4 h0 = acc[ai][bj][m][0], h1 = acc[ai][bj][m][1];
                    ss += ((h0[0] * h0[0] + h0[1] * h0[1]) + (h0[2] * h0[2] + h0[3] * h0[3])) + ((h1[0] * h1[0] + h1[1] * h1[1]) + (h1[2] * h1[2] + h1[3] * h1[3])); }
                ss += __builtin_bit_cast(float, __builtin_amdgcn_ds_bpermute((lane ^ 16) << 2, __builtin_bit_cast(int, ss)));
                ss += __builtin_bit_cast(float, __builtin_amdgcn_ds_bpermute((lane ^ 32) << 2, __builtin_bit_cast(int, ss)));
                if (fq == 0) P[(ai * HALF + wr * 64 + m * 16 + fr) * 4 + wc] = ss; }
        asm volatile("s_waitcnt lgkmcnt(0)" ::: "memory"); __builtin_amdgcn_s_barrier(); asm volatile("" ::: "memory");
        if (wid < 4) {
            const f32x4 p = *(const PG8_LAS f32x4*)(P + tid * 4); const float bs = (p[0] + p[1]) + (p[2] + p[3]);
            __hip_atomic_store(xbuf + ((size_t)(u.pm * BM + tid) * 4 + u.pn), __builtin_bit_cast(unsigned, bs), __ATOMIC_RELAXED, __HIP_MEMORY_SCOPE_AGENT);
            asm volatile("s_waitcnt vmcnt(0)" ::: "memory");
            if (lane == 0) __hip_atomic_fetch_add(cnt + 64 * u.pm, 1u, __ATOMIC_RELAXED, __HIP_MEMORY_SCOPE_AGENT);
        }
        if (wid == 0) {
            unsigned spins = 0;
            while ((unsigned)__builtin_amdgcn_readfirstlane((int)__hip_atomic_load(cnt + 64 * u.pm, __ATOMIC_RELAXED, __HIP_MEMORY_SCOPE_AGENT)) < target) { __builtin_amdgcn_s_sleep(1); if (++spins > (1u << 21)) break; }
        }
        asm volatile("s_waitcnt vmcnt(0) lgkmcnt(0)" ::: "memory"); __builtin_amdgcn_s_barrier(); asm volatile("" ::: "memory");
        if (wid < 4) {
            const unsigned* slot = xbuf + (size_t)(u.pm * BM + tid) * 4; float s = 0.f;
#pragma unroll
            for (int q = 0; q < 4; ++q) s += __builtin_bit_cast(float, __hip_atomic_load(slot + q, __ATOMIC_RELAXED, __HIP_MEMORY_SCOPE_AGENT));
            S[tid] = __builtin_amdgcn_rsqf(s * (1.0f / 1024.0f) + 1e-5f);
        }
        asm volatile("s_waitcnt vmcnt(0) lgkmcnt(0)" ::: "memory"); __builtin_amdgcn_s_barrier(); asm volatile("" ::: "memory");
        asm volatile("" : "+v"(fr), "+v"(fq));
        const int row0b = u.pm * BM + wr * 64 + fr, col0b = u.pn * BM + wc * 32 + 8 * fq;
        f32x4 gv[2][2];
#pragma unroll
        for (int bj = 0; bj < 2; ++bj) { gv[bj][0] = *(const f32x4*)(gain + col0b + bj * HALF); gv[bj][1] = *(const f32x4*)(gain + col0b + bj * HALF + 4); }
#pragma unroll
        for (int ai = 0; ai < 2; ++ai)
#pragma unroll
            for (int m = 0; m < 4; ++m) { const float r = S[ai * HALF + wr * 64 + m * 16 + fr]; const size_t off = (size_t)(row0b + ai * HALF + m * 16) * ldc + col0b;
#pragma unroll
                for (int bj = 0; bj < 2; ++bj) { const f32x4 h0 = acc[ai][bj][m][0], h1 = acc[ai][bj][m][1]; const f32x4 v0 = h0 * r * gv[bj][0], v1 = h1 * r * gv[bj][1];
                    if constexpr (!FINAL) { u32x4 w; w.x = cvt_pk_bf16(h0[0], h0[1]); w.y = cvt_pk_bf16(h0[2], h0[3]); w.z = cvt_pk_bf16(h1[0], h1[1]); w.w = cvt_pk_bf16(h1[2], h1[3]); *(u32x4*)(hout + off + bj * HALF) = w; }
                    if constexpr (FINAL) { *(f32x4*)(outf + off + bj * HALF) = v0; *(f32x4*)(outf + off + bj * HALF + 4) = v1; }
                    else { u32x4 w; w.x = cvt_pk_bf16(v0[0], v0[1]); w.y = cvt_pk_bf16(v0[2], v0[3]); w.z = cvt_pk_bf16(v1[0], v1[1]); w.w = cvt_pk_bf16(v1[2], v1[3]);
                        *(u32x4*)(hn + off + bj * HALF) = w; } } }
    }
};
struct EpiSwiGLU {
    static constexpr bool PERM = true, AFTER_DRAIN = false;
    bf16_t* O; int ldc;
    __device__ __forceinline__ void operator()(const f32x4 (&acc)[2][2][4][2], const Unit& u, int wr, int wc, int fr, int fq) const {
        const int row0 = u.pm * BM + wr * 64 + fr; const int col0 = u.pn * HALF + wc * 32 + 8 * fq;
#pragma unroll
        for (int ai = 0; ai < 2; ++ai)
#pragma unroll
            for (int m = 0; m < 4; ++m) { bf16_t* rowp = O + (size_t)(row0 + ai * HALF + m * 16) * ldc + col0;
                float o[8];
#pragma unroll
                for (int n = 0; n < 2; ++n)
#pragma unroll
                    for (int j = 0; j < 4; ++j) { const float g = acc[ai][0][m][n][j], up = acc[ai][1][m][n][j];
                        o[n * 4 + j] = g * __builtin_amdgcn_rcpf(1.0f + __builtin_amdgcn_exp2f(-1.44269504f * g)) * up; }
                u32x4 w; w.x = cvt_pk_bf16(o[0], o[1]); w.y = cvt_pk_bf16(o[2], o[3]); w.z = cvt_pk_bf16(o[4], o[5]); w.w = cvt_pk_bf16(o[6], o[7]);
                *(u32x4*)rowp = w; }
    }
};
template <class Epi, class Sched, bool ALIGN_EPI = false, bool SP2 = false>
__device__ __forceinline__ void gemm_phase(PG8_LAS unsigned char* lds, const Gemm g, const Sched& S, const Epi& E) {
    int tid_ = threadIdx.x; asm volatile("" : "+v"(tid_)); const int tid = tid_, wid = __builtin_amdgcn_readfirstlane(tid >> 6), lane = tid & 63, wr = wid >> 2, wc = wid & 3, fr = lane & 15, fq = lane >> 4;
    const int K = g.K, nt = K / BK;
    unsigned voffA[2], voffB[2];
#pragma unroll
    for (int i = 0; i < 2; ++i) { int R, C; stage_rc(tid * 16 + i * 8192, R, C); const int Rb = Epi::PERM ? ((R & ~31) + perm32(R & 31)) : R;
        voffA[i] = (unsigned)(R * K + C) * 2u; voffB[i] = (unsigned)(Rb * K + C) * 2u; }
    const size_t kstep = (size_t)(BK * 2);
    const size_t hstep = (size_t)HALF * K * 2;
    const size_t tstep = 2 * hstep;
    const unsigned ldsw = (unsigned)wid * 1024u;
    const int aoff = lds_byte(wr * 64 + fr, fq * 8), boff = lds_byte(wc * 32 + fr, fq * 8);
#define PG8_SA(b, h) (((b) * 2 + (h)) * HTB)
#define PG8_SB(b, h) ((4 + (b) * 2 + (h)) * HTB)
#define PG8_STAGE(bufoff, gbase, voff) do { _Pragma("unroll") for (int _i = 0; _i < 2; ++_i) \
        __builtin_amdgcn_global_load_lds((const unsigned*)((const char*)(gbase) + (voff)[_i]), (PG8_LAS unsigned*)(lds + (bufoff) + ldsw + _i * 8192), 16, 0, 0); } while (0)
#define PG8_LDA(dst, b, h) do { _Pragma("unroll") for (int m = 0; m < 4; ++m) _Pragma("unroll") for (int k = 0; k < 2; ++k) dst[m][k] = *(const PG8_LAS bf16x8*)(lds + PG8_SA(b, h) + aoff + m * 2048 + k * 1024); } while (0)
#define PG8_LDB(dst, b, h) do { _Pragma("unroll") for (int n = 0; n < 2; ++n) _Pragma("unroll") for (int k = 0; k < 2; ++k) dst[n][k] = *(const PG8_LAS bf16x8*)(lds + PG8_SB(b, h) + boff + n * 2048 + k * 1024); } while (0)
#define PG8_MMA(ai, bj, At, Bt) do { __builtin_amdgcn_s_setprio(1); _Pragma("unroll") for (int m = 0; m < 4; ++m) _Pragma("unroll") for (int n = 0; n < 2; ++n) _Pragma("unroll") for (int k = 0; k < 2; ++k) \
        acc[ai][bj][m][n] = __builtin_amdgcn_mfma_f32_16x16x32_bf16(Bt[n][k], At[m][k], acc[ai][bj][m][n], 0, 0, 0); __builtin_amdgcn_s_setprio(0); } while (0)
#define PG8_WAIT_V(n) asm volatile("s_waitcnt vmcnt(" #n ")" ::: "memory")
#define PG8_WAIT_L(n) asm volatile("s_waitcnt lgkmcnt(" #n ")" ::: "memory")
#define PG8_BAR __builtin_amdgcn_s_barrier()
#define PG8_SCHED __builtin_amdgcn_sched_barrier(0)
    Unit cur, nxt; int ui = 0;
    if (!S.next(0, cur)) return;
    f32x4 acc[2][2][4][2];
#pragma unroll
    for (int a = 0; a < 2; ++a)
#pragma unroll
        for (int b = 0; b < 2; ++b)
#pragma unroll
            for (int m = 0; m < 4; ++m)
#pragma unroll
                for (int n = 0; n < 2; ++n) acc[a][b][m][n] = (f32x4){0.f, 0.f, 0.f, 0.f};
    bf16x8 At[4][2], B0[2][2], B1[2][2];
    const char* cA = (const char*)g.A + (size_t)cur.pm * tstep; const char* cB = (const char*)g.Bt + (size_t)cur.pn * tstep;
    S.a_ready(cur);
    if constexpr (SP2) {
        PG8_STAGE(PG8_SB(0, 0), cB, voffB); PG8_STAGE(PG8_SB(0, 1), cB + hstep, voffB); PG8_STAGE(PG8_SA(0, 0), cA, voffA); PG8_STAGE(PG8_SA(0, 1), cA + hstep, voffA);
        if (wr == 1) PG8_BAR;
        PG8_WAIT_V(2); PG8_BAR;
        PG8_STAGE(PG8_SB(1, 0), cB + kstep, voffB); PG8_STAGE(PG8_SA(1, 0), cA + kstep, voffA); PG8_STAGE(PG8_SB(1, 1), cB + hstep + kstep, voffB);
        PG8_WAIT_V(6); PG8_BAR;
    } else {
        PG8_STAGE(PG8_SB(0, 0), cB, voffB); PG8_STAGE(PG8_SA(0, 0), cA, voffA); PG8_STAGE(PG8_SB(0, 1), cB + hstep, voffB); PG8_STAGE(PG8_SA(0, 1), cA + hstep, voffA);
        if (wr == 1) PG8_BAR;
        PG8_WAIT_V(4); PG8_BAR;
        PG8_STAGE(PG8_SB(1, 0), cB + kstep, voffB); PG8_STAGE(PG8_SA(1, 0), cA + kstep, voffA); PG8_STAGE(PG8_SB(1, 1), cB + hstep + kstep, voffB);
        PG8_WAIT_V(6); PG8_BAR;
    }
    for (;;) {
        const bool has_next = S.next(ui + 1, nxt);
        const char* nA = has_next ? (const char*)g.A + (size_t)nxt.pm * tstep : cA; const char* nB = has_next ? (const char*)g.Bt + (size_t)nxt.pn * tstep : cB;
        for (int t = 0; t < nt; t += 2) {
            const bool last = (t == nt - 2);
            const char* a1 = cA + (size_t)(t + 1) * kstep;
            const char* a2 = last ? nA : cA + (size_t)(t + 2) * kstep; const char* b2 = last ? nB : cB + (size_t)(t + 2) * kstep;
            const char* a3 = a2 + kstep; const char* b3 = b2 + kstep;
            if (last && has_next) S.a_ready(nxt);
            if constexpr (SP2) {
            PG8_LDB(B0, 0, 0); PG8_LDB(B1, 0, 1); PG8_SCHED; PG8_LDA(At, 0, 0); PG8_STAGE(PG8_SA(1, 1), a1 + hstep, voffA);
            PG8_WAIT_V(8); PG8_WAIT_L(0); PG8_BAR; PG8_MMA(0, 0, At, B0); PG8_MMA(0, 1, At, B1); PG8_BAR; PG8_SCHED;
            PG8_LDA(At, 0, 1); PG8_STAGE(PG8_SB(0, 0), b2, voffB); PG8_STAGE(PG8_SB(0, 1), b2 + hstep, voffB); PG8_STAGE(PG8_SA(0, 0), a2, voffA);
            PG8_WAIT_V(8); PG8_WAIT_L(0); PG8_BAR; PG8_MMA(1, 0, At, B0); PG8_MMA(1, 1, At, B1); PG8_BAR; PG8_SCHED;
            PG8_LDB(B0, 1, 0); PG8_LDB(B1, 1, 1); PG8_SCHED; PG8_LDA(At, 1, 0); PG8_STAGE(PG8_SA(0, 1), a2 + hstep, voffA);
            PG8_WAIT_V(8); PG8_WAIT_L(0); PG8_BAR; PG8_MMA(0, 0, At, B0); PG8_MMA(0, 1, At, B1); PG8_BAR; PG8_SCHED;
            PG8_LDA(At, 1, 1); PG8_STAGE(PG8_SB(1, 0), b3, voffB); PG8_STAGE(PG8_SB(1, 1), b3 + hstep, voffB); PG8_STAGE(PG8_SA(1, 0), a3, voffA);
            PG8_WAIT_V(8); PG8_WAIT_L(0); PG8_BAR; PG8_MMA(1, 0, At, B0); PG8_MMA(1, 1, At, B1); PG8_BAR; PG8_SCHED;
            } else {
            PG8_LDB(B0, 0, 0); PG8_SCHED; PG8_LDA(At, 0, 0); PG8_STAGE(PG8_SA(1, 1), a1 + hstep, voffA);
            PG8_WAIT_L(8); PG8_BAR; PG8_WAIT_L(0); PG8_MMA(0, 0, At, B0); PG8_BAR; PG8_SCHED;
            PG8_LDB(B1, 0, 1); PG8_STAGE(PG8_SB(0, 0), b2, voffB);
            PG8_BAR; PG8_WAIT_L(0); PG8_MMA(0, 1, At, B1); PG8_BAR;
            PG8_LDA(At, 0, 1); PG8_STAGE(PG8_SA(0, 0), a2, voffA);
            PG8_BAR; PG8_WAIT_L(0); PG8_MMA(1, 0, At, B0); PG8_BAR; PG8_SCHED;
            PG8_STAGE(PG8_SB(0, 1), b2 + hstep, voffB);
            PG8_WAIT_V(6); PG8_BAR; PG8_MMA(1, 1, At, B1); PG8_BAR;
            PG8_LDB(B0, 1, 0); PG8_SCHED; PG8_LDA(At, 1, 0); PG8_STAGE(PG8_SA(0, 1), a2 + hstep, voffA);
            PG8_WAIT_L(8); PG8_BAR; PG8_WAIT_L(0); PG8_MMA(0, 0, At, B0); PG8_BAR; PG8_SCHED;
            PG8_LDB(B1, 1, 1); PG8_STAGE(PG8_SB(1, 0), b3, voffB);
            PG8_BAR; PG8_WAIT_L(0); PG8_MMA(0, 1, At, B1); PG8_BAR;
            PG8_LDA(At, 1, 1); PG8_STAGE(PG8_SA(1, 0), a3, voffA);
            PG8_BAR; PG8_WAIT_L(0); PG8_MMA(1, 0, At, B0); PG8_BAR; PG8_SCHED;
            PG8_STAGE(PG8_SB(1, 1), b3 + hstep, voffB);
            PG8_WAIT_V(6); PG8_BAR; PG8_MMA(1, 1, At, B1); PG8_BAR;
            }
        }
        if constexpr (ALIGN_EPI) { if (wr == 0) PG8_BAR; }
        if constexpr (!Epi::AFTER_DRAIN) { E(acc, cur, wr, wc, fr, fq); S.done(cur); }
        if (!has_next) break;
#pragma unroll
        for (int a = 0; a < 2; ++a)
#pragma unroll
            for (int b = 0; b < 2; ++b)
#pragma unroll
                for (int m = 0; m < 4; ++m)
#pragma unroll
                    for (int n = 0; n < 2; ++n) acc[a][b][m][n] = (f32x4){0.f, 0.f, 0.f, 0.f};
        cur = nxt; cA = nA; cB = nB; ++ui;
        if constexpr (ALIGN_EPI) { if (wr == 1) PG8_BAR; }
    }
    PG8_WAIT_V(0);
    if constexpr (!ALIGN_EPI) { if (wr == 0) PG8_BAR; }
    PG8_BAR;
    if constexpr (Epi::AFTER_DRAIN) { E.fused(acc, cur, wr, wc, fr, fq, lds, wid, lane); S.done(cur); }
#undef PG8_SA
#undef PG8_SB
#undef PG8_STAGE
#undef PG8_LDA
#undef PG8_LDB
#undef PG8_MMA
#undef PG8_WAIT_V
#undef PG8_WAIT_L
#undef PG8_BAR
#undef PG8_SCHED
}
}

namespace cg = cooperative_groups;
#define LAS __attribute__((address_space(3)))
typedef unsigned short bf16;
typedef float f32x4 __attribute__((ext_vector_type(4)));
typedef float f32x2 __attribute__((ext_vector_type(2)));
typedef short bf16x8 __attribute__((ext_vector_type(8)));
typedef unsigned u32x4 __attribute__((ext_vector_type(4)));
typedef unsigned u32x2 __attribute__((ext_vector_type(2)));

constexpr int NT = 65536, DM = 1024, SEQ = 4096, NB = 16, DEPTH = 4;
constexpr int P_EVEN = 2816, P_A = 1792, P_ODD = 1536, FF = 2816;
constexpr int NTHREADS = 512, NWAVES = 8;
constexpr int LDS_BYTES = 147456;
constexpr int XB_LDS_OFF = LDS_BYTES - 64;

constexpr size_t MiB = 1u << 20;
constexpr size_t WS_EVIN = 0;
constexpr size_t WS_ODIN = 11 * MiB;
constexpr size_t WS_WOUT = 17 * MiB;
constexpr size_t WS_GU   = 25 * MiB;
constexpr size_t WS_DN   = 69 * MiB;
constexpr size_t WS_SPW  = 91 * MiB;
constexpr size_t WS_GUPT = WS_SPW + 256 * 1024;
constexpr size_t WS_WUPT = WS_GUPT + 256 * 1024;
constexpr size_t WS_AUPT = WS_WUPT + 128 * 1024;
constexpr size_t WS_BON  = 92 * MiB;
constexpr size_t WS_HN   = 96 * MiB;
constexpr size_t WS_PROJ = 224 * MiB;
constexpr size_t WS_YCAT = 576 * MiB;
constexpr size_t WS_YS   = 704 * MiB;
constexpr size_t WS_H    = 832 * MiB;
constexpr size_t WS_CTL  = 960 * MiB;
constexpr size_t WS_CNT  = WS_CTL + 16384;
constexpr size_t WS_XB   = WS_CTL + 262144;
constexpr size_t WS_END  = 963 * MiB;

struct Args { const float* in[32]; float* out; unsigned char* ws; };

__device__ __forceinline__ unsigned f2bf(float f) { unsigned u = __builtin_bit_cast(unsigned, f); return (u + 0x7fffu + ((u >> 16) & 1u)) >> 16; }
__device__ __forceinline__ unsigned pk2(float lo, float hi) { unsigned r; asm volatile("v_cvt_pk_bf16_f32 %0, %1, %2" : "=v"(r) : "v"(lo), "v"(hi)); return r; }
__device__ __forceinline__ float bflo(unsigned w) { return __builtin_bit_cast(float, w << 16); }
__device__ __forceinline__ float bfhi(unsigned w) { return __builtin_bit_cast(float, w & 0xffff0000u); }
__device__ __forceinline__ float bf1(bf16 b) { return __builtin_bit_cast(float, ((unsigned)b) << 16); }
__device__ __forceinline__ float sigmoidf_(float x) { return __builtin_amdgcn_rcpf(1.0f + __builtin_amdgcn_exp2f(-1.44269504f * x)); }

template <int CTRL> __device__ __forceinline__ float dppf(float x) { const int v = __builtin_bit_cast(int, x); return __builtin_bit_cast(float, __builtin_amdgcn_update_dpp(v, v, CTRL, 0xF, 0xF, true)); }
__device__ __forceinline__ float sum8(float x)  { x += dppf<0xB1>(x); x += dppf<0x4E>(x); x += dppf<0x141>(x); return x; }
__device__ __forceinline__ float sum16(float x) { x += dppf<0xB1>(x); x += dppf<0x4E>(x); x += dppf<0x141>(x); x += dppf<0x140>(x); return x; }
__device__ __forceinline__ float rdl(float x, int l) { return __builtin_bit_cast(float, __builtin_amdgcn_readlane(__builtin_bit_cast(int, x), l)); }
__device__ __forceinline__ float wave_sum(float v) { v = sum16(v); return (rdl(v, 0) + rdl(v, 16)) + (rdl(v, 32) + rdl(v, 48)); }
__device__ __forceinline__ float shx(float v, int lane, int o) { return __builtin_bit_cast(float, __builtin_amdgcn_ds_bpermute((lane ^ o) << 2, __builtin_bit_cast(int, v))); }
#define LDS_WAIT() asm volatile("s_waitcnt lgkmcnt(0)" ::: "memory")

__device__ __forceinline__ void transpose_item(const float* W, int ldw, int k0, int n0, bf16* WT, int ldt, int drow0, LAS float* scr, int lane) {
#pragma unroll 8
    for (int i = 0; i < 32; ++i) { const int kk = 2 * i + (lane >> 5); scr[kk * 33 + (lane & 31)] = W[(size_t)(k0 + kk) * ldw + n0 + (lane & 31)]; }
    LDS_WAIT(); asm volatile("" ::: "memory");
    const int c = lane & 7;
#pragma unroll
    for (int j = 0; j < 4; ++j) { const int n = (lane >> 3) + 8 * j; const LAS float* s = scr + (8 * c) * 33 + n;
        u32x4 o; o.x = pk2(s[0 * 33], s[1 * 33]); o.y = pk2(s[2 * 33], s[3 * 33]); o.z = pk2(s[4 * 33], s[5 * 33]); o.w = pk2(s[6 * 33], s[7 * 33]);
        *(u32x4*)(WT + (size_t)(drow0 + n) * ldt + k0 + 8 * c) = o; }
    LDS_WAIT(); asm volatile("" ::: "memory");
}

__device__ __forceinline__ void prep_phase(const Args& a, LAS unsigned char* lds) {
    int tid_ = threadIdx.x; asm volatile("" : "+v"(tid_)); const int tid = tid_, lane = tid & 63, wave = tid >> 6;
    LAS float* scr = (LAS float*)(lds + wave * 8704);
    const int gw = blockIdx.x * NWAVES + wave, NGW = gridDim.x * NWAVES;
    unsigned char* ws = a.ws;
    constexpr int I_EVIN = 16 * 88, I_ODIN = 16 * 48, I_EVO = 16 * 32, I_ODO = 8 * 32, I_GU = 16 * 88, I_DN = 44 * 32, I_LW = 16, I_LG = 32;
    constexpr int NITEMS = 2 * I_EVIN + 2 * I_ODIN + 2 * I_EVO + 2 * I_ODO + 8 * I_GU + 4 * I_DN + 4 * I_LW + 2 * I_LG;
    for (int it = gw; it < NITEMS; it += NGW) {
        int r = it;
        if (r < 2 * I_EVIN) { const int i = r / I_EVIN; r %= I_EVIN; const int kb = r / 88, nb = r % 88;
            transpose_item(a.in[4] + (size_t)i * DM * P_EVEN, P_EVEN, kb * 64, nb * 32, (bf16*)(ws + WS_EVIN) + (size_t)i * P_EVEN * DM, DM, nb * 32, scr, lane); continue; } r -= 2 * I_EVIN;
        if (r < 2 * I_ODIN) { const int i = r / I_ODIN; r %= I_ODIN; const int kb = r / 48, nb = r % 48;
            transpose_item(a.in[21] + (size_t)i * DM * P_ODD, P_ODD, kb * 64, nb * 32, (bf16*)(ws + WS_ODIN) + (size_t)i * P_ODD * DM, DM, nb * 32, scr, lane); continue; } r -= 2 * I_ODIN;
        if (r < 2 * I_EVO) { const int i = r / I_EVO; r %= I_EVO; const int kb = r / 32, nb = r % 32;
            transpose_item(a.in[20] + (size_t)i * DM * DM, DM, kb * 64, nb * 32, (bf16*)(ws + WS_WOUT) + (size_t)(2 * i) * DM * DM, DM, nb * 32, scr, lane); continue; } r -= 2 * I_EVO;
        if (r < 2 * I_ODO) { const int i = r / I_ODO; r %= I_ODO; const int kb = r / 32, nb = r % 32;
            transpose_item(a.in[28] + (size_t)i * DM * DM, DM, kb * 64, nb * 32, (bf16*)(ws + WS_WOUT) + (size_t)(2 * i + 1) * DM * DM, DM, nb * 32, scr, lane); continue; } r -= 2 * I_ODO;
        if (r < 8 * I_GU) { const int l = r / (2 * I_GU); r %= 2 * I_GU; const int up = r / I_GU; r %= I_GU; const int kb = r / 88, nb = r % 88; const int n0 = nb * 32;
            transpose_item((up ? a.in[30] : a.in[29]) + (size_t)l * DM * FF, FF, kb * 64, n0, (bf16*)(ws + WS_GU) + (size_t)l * 2 * FF * DM, DM, (n0 >> 7) * 256 + (n0 & 127) + up * 128, scr, lane); continue; } r -= 8 * I_GU;
        if (r < 4 * I_DN) { const int l = r / I_DN; r %= I_DN; const int kb = r / 32, nb = r % 32;
            transpose_item(a.in[31] + (size_t)l * FF * DM, DM, kb * 64, nb * 32, (bf16*)(ws + WS_DN) + (size_t)l * DM * FF, FF, nb * 32, scr, lane); continue; } r -= 4 * I_DN;
        if (r < 4 * I_LW) { const int which = r / (2 * I_LW); r %= 2 * I_LW; const int i = r / I_LW; const int nb = r % I_LW;
            transpose_item((which ? a.in[9] : a.in[7]) + (size_t)i * 64 * 512, 512, 0, nb * 32, (bf16*)(ws + (which ? WS_AUPT : WS_WUPT)) + (size_t)i * 512 * 64, 64, nb * 32, scr, lane); continue; } r -= 4 * I_LW;
        { const int i = r / I_LG; r %= I_LG; const int kb = r / 16, nb = r % 16;
            transpose_item(a.in[10] + (size_t)i * 128 * 512, 512, kb * 64, nb * 32, (bf16*)(ws + WS_GUPT) + (size_t)i * 512 * 128, 128, nb * 32, scr, lane); }
    }
    const int gt = blockIdx.x * NTHREADS + tid, NGT = gridDim.x * NTHREADS;
    for (int e = gt; e < 2 * 4 * 128 * 128; e += NGT) { const int j = e & 127, i = (e >> 7) & 127; const float v = (j <= i) ? a.in[18][e] : 0.f; ((bf16*)(ws + WS_SPW))[e] = (bf16)f2bf(v); }
    for (int e = gt; e < 2 * 1024 * 4 * 16; e += NGT) {
        const int o = e & 1023, ib = (e >> 10) & 15, g = (e >> 14) & 3, i = e >> 16;
        const float* pw = a.in[26] + ((size_t)(i * 4 + g) * 128 + ib * 8) * 128; const float* sc = a.in[27] + i * 512 + g * 128; const float* wo = a.in[28] + (size_t)i * DM * DM + (size_t)(512 + g * 128) * DM + o;
        float acc[8];
#pragma unroll
        for (int q = 0; q < 8; ++q) acc[q] = 0.f;
        for (int j = 0; j < 128; ++j) { const float wv = wo[(size_t)j * DM] * sc[j];
#pragma unroll
            for (int q = 0; q < 8; ++q) acc[q] += pw[q * 128 + j] * wv; }
        u32x4 w; w.x = pk2(acc[0], acc[1]); w.y = pk2(acc[2], acc[3]); w.z = pk2(acc[4], acc[5]); w.w = pk2(acc[6], acc[7]);
        *(u32x4*)((bf16*)(ws + WS_WOUT) + (size_t)(2 * i + 1) * DM * DM + (size_t)o * DM + 512 + g * 128 + ib * 8) = w;
    }
}

__device__ __forceinline__ void rmsnorm_phase(const float* __restrict__ xin, const bf16* __restrict__ hb, const float* __restrict__ g, bf16* __restrict__ hn, bf16* __restrict__ hstream) {
    int tid_ = threadIdx.x; asm volatile("" : "+v"(tid_)); const int lane = tid_ & 63, wave = tid_ >> 6; const int gw = blockIdx.x * NWAVES + wave, NGW = gridDim.x * NWAVES;
    f32x4 gv[4];
#pragma unroll
    for (int j = 0; j < 4; ++j) gv[j] = ((const f32x4*)g)[lane + 64 * j];
    if (xin) {
        for (int m = gw; m < NT; m += NGW) {
            f32x4 v[4]; float s = 0.f; const f32x4* xr = (const f32x4*)(xin + (size_t)m * DM) + lane;
#pragma unroll
            for (int j = 0; j < 4; ++j) v[j] = xr[64 * j];
#pragma unroll
            for (int j = 0; j < 4; ++j) s += (v[j].x * v[j].x + v[j].y * v[j].y) + (v[j].z * v[j].z + v[j].w * v[j].w);
            const float r = 1.0f / sqrtf(wave_sum(s) * (1.f / DM) + 1e-5f);
            u32x2* o8 = (u32x2*)(hn + (size_t)m * DM) + lane; u32x2* s8 = (u32x2*)(hstream + (size_t)m * DM) + lane;
#pragma unroll
            for (int j = 0; j < 4; ++j) { u32x2 w; w.x = pk2(v[j].x * r * gv[j].x, v[j].y * r * gv[j].y); w.y = pk2(v[j].z * r * gv[j].z, v[j].w * r * gv[j].w); o8[64 * j] = w;
                u32x2 q; q.x = pk2(v[j].x, v[j].y); q.y = pk2(v[j].z, v[j].w); s8[64 * j] = q; }
        }
    } else {
        for (int m = gw; m < NT; m += 4 * NGW) {
            u32x2 w[4][4];
#pragma unroll
            for (int q = 0; q < 4; ++q) { const u32x2* xr = (const u32x2*)(hb + (size_t)(m + q * NGW) * DM) + lane;
#pragma unroll
                for (int j = 0; j < 4; ++j) w[q][j] = (m + q * NGW < NT) ? xr[64 * j] : (u32x2){0u, 0u}; }
#pragma unroll
            for (int q = 0; q < 4; ++q) { f32x4 v[4]; float s = 0.f;
#pragma unroll
                for (int j = 0; j < 4; ++j) { v[j] = (f32x4){bflo(w[q][j].x), bfhi(w[q][j].x), bflo(w[q][j].y), bfhi(w[q][j].y)}; s += (v[j].x * v[j].x + v[j].y * v[j].y) + (v[j].z * v[j].z + v[j].w * v[j].w); }
                const float r = 1.0f / sqrtf(wave_sum(s) * (1.f / DM) + 1e-5f);
                u32x2* o8 = (u32x2*)(hn + (size_t)(m + q * NGW) * DM) + lane;
#pragma unroll
                for (int j = 0; j < 4; ++j) { u32x2 o; o.x = pk2(v[j].x * r * gv[j].x, v[j].y * r * gv[j].y); o.y = pk2(v[j].z * r * gv[j].z, v[j].w * r * gv[j].w); if (m + q * NGW < NT) o8[64 * j] = o; } }
        }
    }
}
__device__ __forceinline__ void final_norm_phase(const bf16* hb, float* out, const float* g) {
    int tid_ = threadIdx.x; asm volatile("" : "+v"(tid_)); const int lane = tid_ & 63, wave = tid_ >> 6; const int gw = blockIdx.x * NWAVES + wave, NGW = gridDim.x * NWAVES;
    f32x4 gv[4];
#pragma unroll
    for (int j = 0; j < 4; ++j) gv[j] = ((const f32x4*)g)[lane + 64 * j];
    for (int m = gw; m < NT; m += NGW) {
        const u32x2* xr = (const u32x2*)(hb + (size_t)m * DM) + lane; f32x4 v[4]; float s = 0.f;
#pragma unroll
        for (int j = 0; j < 4; ++j) { const u32x2 w = xr[64 * j]; v[j] = (f32x4){bflo(w.x), bfhi(w.x), bflo(w.y), bfhi(w.y)}; s += (v[j].x * v[j].x + v[j].y * v[j].y) + (v[j].z * v[j].z + v[j].w * v[j].w); }
        const float r = 1.0f / sqrtf(wave_sum(s) * (1.f / DM) + 1e-5f);
        f32x4* orow = (f32x4*)(out + (size_t)m * DM) + lane;
#pragma unroll
        for (int j = 0; j < 4; ++j) orow[64 * j] = v[j] * r * gv[j];
    }
}

constexpr int SC_L = 32;
constexpr int SB_R = 0, SB_W = 8192, SB_K = 16384, SB_V = 24576, SB_KK = 32768, SB_B = 40960, SB_SIZE = 49152;
constexpr int SC_KRAW = 2 * SB_SIZE;
constexpr int SC_TW = SC_KRAW + 8192, SC_AD = SC_TW + 32 * 144;
constexpr int SC_WUP = SC_AD + 32 * 144, SC_AUP = SC_WUP + 64 * 144;
constexpr int SC_Y = SC_AUP + 64 * 144;
constexpr int SC_BON = SC_Y + 2 * 4096;
constexpr int SC_CNT = SC_BON + 512;
static_assert(SC_CNT + 16 <= LDS_BYTES, "scan LDS");

#define LERP1(c, p, m) ((c) + ((p) - (c)) * (m))
struct StepVec { f32x4 kA, kB, wA, wB, bA, bB, cA, cB, rA, rB; float vv; };
__device__ __forceinline__ void unpack8(const u32x4 w, float (&x)[8]) { x[0] = bflo(w.x); x[1] = bfhi(w.x); x[2] = bflo(w.y); x[3] = bfhi(w.y); x[4] = bflo(w.z); x[5] = bfhi(w.z); x[6] = bflo(w.w); x[7] = bfhi(w.w); }

__device__ __forceinline__ void scan_phase(const Args& a, int li, LAS unsigned char* lds) {
    unsigned char* wsl = a.ws; asm volatile("" : "+s"(wsl));
    int tid_ = threadIdx.x; asm volatile("" : "+v"(tid_)); const int tid = tid_, lane = tid & 63, wave = __builtin_amdgcn_readfirstlane(tid >> 6);
    const bf16* proj = (const bf16*)(wsl + WS_PROJ); bf16* ys = (bf16*)(wsl + WS_YS); float* bong = (float*)(wsl + WS_BON);
    const float* mu = a.in[5] + li * P_A; const float* w0 = a.in[6] + li * 512; const float* a0 = a.in[8] + li * 512;
    const float* k_k = a.in[11] + li * 512; const float* k_a = a.in[12] + li * 512; const float* r_k = a.in[13] + li * 512;
    for (int unit = blockIdx.x; unit < 256; unit += gridDim.x) {
        const int half = unit & 1, bh = unit >> 1, h = bh & 7, b = bh >> 3;
        { const int row = tid >> 3, seg = tid & 7;
          *(LAS u32x4*)(lds + SC_WUP + row * 144 + seg * 16) = *(const u32x4*)((const bf16*)(wsl + WS_WUPT) + (size_t)li * 512 * 64 + (size_t)(64 * h + row) * 64 + seg * 8);
          *(LAS u32x4*)(lds + SC_AUP + row * 144 + seg * 16) = *(const u32x4*)((const bf16*)(wsl + WS_AUPT) + (size_t)li * 512 * 64 + (size_t)(64 * h + row) * 64 + seg * 8);
          if (tid == 0) *(LAS unsigned*)(lds + SC_CNT) = 0u; }
        __syncthreads();
        if (wave >= 4) {
            const int pw = wave - 4, tb = pw >> 1, jh = pw & 1, ptid = tid - 256;
            const int tl = lane >> 3, q8 = lane & 7; const int t1 = pw * 8 + tl;
            const int cR = 64 * h + 8 * q8, cK = 512 + cR, cV = 1024 + cR, cWD = 1536 + 8 * q8, cAD = 1600 + 8 * q8;
            const int n2 = lane & 15, q2 = lane >> 4; const int t2 = tb * 16 + n2;
            u32x4 cur[5], prv[5];
#define SC_FETCH(cc_) do { const int p0_ = (cc_) * SC_L; const bf16* projc = proj; asm volatile("" : "+s"(projc)); const bf16* rp = projc + ((size_t)b * SEQ + p0_ + t1) * P_EVEN; \
                cur[0] = *(const u32x4*)(rp + cR); cur[1] = *(const u32x4*)(rp + cK); cur[2] = *(const u32x4*)(rp + cV); cur[3] = *(const u32x4*)(rp + cWD); cur[4] = *(const u32x4*)(rp + cAD); \
                _Pragma("unroll") for (int g = 0; g < 5; ++g) prv[g] = (u32x4){0u, 0u, 0u, 0u}; \
                if (p0_ + t1 > 0) { const bf16* pp = rp - P_EVEN; prv[0] = *(const u32x4*)(pp + cR); prv[1] = *(const u32x4*)(pp + cK); prv[2] = *(const u32x4*)(pp + cV); prv[3] = *(const u32x4*)(pp + cWD); prv[4] = *(const u32x4*)(pp + cAD); } } while (0)
            SC_FETCH(0);
            for (int cc = 0; cc <= SEQ / SC_L; ++cc) {
                if (cc < SEQ / SC_L) {
                    const int bo = (cc & 1) * SB_SIZE; const int t = t1;
                    { float c8[8], p8[8], o[8], m8[8], kk8[8];
                        { const f32x4 m0_ = *(const f32x4*)(mu + cR), m1_ = *(const f32x4*)(mu + cR + 4); m8[0] = m0_.x; m8[1] = m0_.y; m8[2] = m0_.z; m8[3] = m0_.w; m8[4] = m1_.x; m8[5] = m1_.y; m8[6] = m1_.z; m8[7] = m1_.w; }
                        unpack8(cur[0], c8); unpack8(prv[0], p8);
#pragma unroll
                        for (int e = 0; e < 8; ++e) o[e] = LERP1(c8[e], p8[e], m8[e]);
                        *(LAS f32x4*)(lds + bo + SB_R + t * 256 + q8 * 32) = (f32x4){o[0], o[1], o[2], o[3]}; *(LAS f32x4*)(lds + bo + SB_R + t * 256 + q8 * 32 + 16) = (f32x4){o[4], o[5], o[6], o[7]};
                        { const f32x4 m0_ = *(const f32x4*)(mu + cV), m1_ = *(const f32x4*)(mu + cV + 4); m8[0] = m0_.x; m8[1] = m0_.y; m8[2] = m0_.z; m8[3] = m0_.w; m8[4] = m1_.x; m8[5] = m1_.y; m8[6] = m1_.z; m8[7] = m1_.w; }
                        unpack8(cur[2], c8); unpack8(prv[2], p8);
#pragma unroll
                        for (int e = 0; e < 8; ++e) o[e] = LERP1(c8[e], p8[e], m8[e]);
                        *(LAS f32x4*)(lds + bo + SB_V + t * 256 + q8 * 32) = (f32x4){o[0], o[1], o[2], o[3]}; *(LAS f32x4*)(lds + bo + SB_V + t * 256 + q8 * 32 + 16) = (f32x4){o[4], o[5], o[6], o[7]};
                        { const f32x4 m0_ = *(const f32x4*)(mu + cK), m1_ = *(const f32x4*)(mu + cK + 4); m8[0] = m0_.x; m8[1] = m0_.y; m8[2] = m0_.z; m8[3] = m0_.w; m8[4] = m1_.x; m8[5] = m1_.y; m8[6] = m1_.z; m8[7] = m1_.w; } { const f32x4 m0_ = *(const f32x4*)(k_k + cR), m1_ = *(const f32x4*)(k_k + cR + 4); kk8[0] = m0_.x; kk8[1] = m0_.y; kk8[2] = m0_.z; kk8[3] = m0_.w; kk8[4] = m1_.x; kk8[5] = m1_.y; kk8[6] = m1_.z; kk8[7] = m1_.w; }
                        unpack8(cur[1], c8); unpack8(prv[1], p8); float ss = 0.f;
#pragma unroll
                        for (int e = 0; e < 8; ++e) { o[e] = LERP1(c8[e], p8[e], m8[e]); c8[e] = o[e] * kk8[e]; ss += c8[e] * c8[e]; }
                        *(LAS f32x4*)(lds + SC_KRAW + t * 256 + q8 * 32) = (f32x4){o[0], o[1], o[2], o[3]}; *(LAS f32x4*)(lds + SC_KRAW + t * 256 + q8 * 32 + 16) = (f32x4){o[4], o[5], o[6], o[7]};
                        ss = sum8(ss); const float inv = 1.0f / fmaxf(sqrtf(ss), 1e-12f);
                        *(LAS f32x4*)(lds + bo + SB_KK + t * 256 + q8 * 32) = (f32x4){c8[0] * inv, c8[1] * inv, c8[2] * inv, c8[3] * inv}; *(LAS f32x4*)(lds + bo + SB_KK + t * 256 + q8 * 32 + 16) = (f32x4){c8[4] * inv, c8[5] * inv, c8[6] * inv, c8[7] * inv};
                        { const f32x4 m0_ = *(const f32x4*)(mu + cWD), m1_ = *(const f32x4*)(mu + cWD + 4); m8[0] = m0_.x; m8[1] = m0_.y; m8[2] = m0_.z; m8[3] = m0_.w; m8[4] = m1_.x; m8[5] = m1_.y; m8[6] = m1_.z; m8[7] = m1_.w; }
                        unpack8(cur[3], c8); unpack8(prv[3], p8);
#pragma unroll
                        for (int e = 0; e < 8; ++e) { const float xw = LERP1(c8[e], p8[e], m8[e]); o[e] = 1.0f - 2.0f * __builtin_amdgcn_rcpf(1.0f + __builtin_amdgcn_exp2f(2.88539008f * xw)); }
                        { u32x4 w; w.x = pk2(o[0], o[1]); w.y = pk2(o[2], o[3]); w.z = pk2(o[4], o[5]); w.w = pk2(o[6], o[7]); *(LAS u32x4*)(lds + SC_TW + t * 144 + q8 * 16) = w; }
                        { const f32x4 m0_ = *(const f32x4*)(mu + cAD), m1_ = *(const f32x4*)(mu + cAD + 4); m8[0] = m0_.x; m8[1] = m0_.y; m8[2] = m0_.z; m8[3] = m0_.w; m8[4] = m1_.x; m8[5] = m1_.y; m8[6] = m1_.z; m8[7] = m1_.w; }
                        unpack8(cur[4], c8); unpack8(prv[4], p8);
#pragma unroll
                        for (int e = 0; e < 8; ++e) o[e] = LERP1(c8[e], p8[e], m8[e]);
                        { u32x4 w; w.x = pk2(o[0], o[1]); w.y = pk2(o[2], o[3]); w.z = pk2(o[4], o[5]); w.w = pk2(o[6], o[7]); *(LAS u32x4*)(lds + SC_AD + t * 144 + q8 * 16) = w; } }
                    if (cc + 1 < SEQ / SC_L) SC_FETCH(cc + 1);
                    LDS_WAIT();
                    if (lane == 0) __hip_atomic_fetch_add((LAS unsigned*)(lds + SC_CNT), 1u, __ATOMIC_RELAXED, __HIP_MEMORY_SCOPE_WORKGROUP);
                    while (__hip_atomic_load((LAS unsigned*)(lds + SC_CNT), __ATOMIC_RELAXED, __HIP_MEMORY_SCOPE_WORKGROUP) < 4u * (unsigned)(cc + 1)) __builtin_amdgcn_s_sleep(1);
                    asm volatile("" ::: "memory");
                    float bp = 0.f;
#pragma unroll
                    for (int jbi = 0; jbi < 2; ++jbi) { const int jb = 2 * jh + jbi, j2 = jb * 16 + 4 * q2;
                        f32x4 accw = {0.f, 0.f, 0.f, 0.f}, acca = {0.f, 0.f, 0.f, 0.f};
#pragma unroll
                        for (int ks = 0; ks < 2; ++ks) {
                            const bf16x8 Aw = *(const LAS bf16x8*)(lds + SC_WUP + (jb * 16 + n2) * 144 + (8 * q2 + 32 * ks) * 2), Aa = *(const LAS bf16x8*)(lds + SC_AUP + (jb * 16 + n2) * 144 + (8 * q2 + 32 * ks) * 2);
                            const bf16x8 Bw = *(const LAS bf16x8*)(lds + SC_TW + t2 * 144 + (8 * q2 + 32 * ks) * 2), Ba = *(const LAS bf16x8*)(lds + SC_AD + t2 * 144 + (8 * q2 + 32 * ks) * 2);
                            accw = __builtin_amdgcn_mfma_f32_16x16x32_bf16(Aw, Bw, accw, 0, 0, 0); acca = __builtin_amdgcn_mfma_f32_16x16x32_bf16(Aa, Ba, acca, 0, 0, 0); }
                        const f32x4 w0v = *(const f32x4*)(w0 + 64 * h + j2), a0v = *(const f32x4*)(a0 + 64 * h + j2), kav = *(const f32x4*)(k_a + 64 * h + j2), rkv = *(const f32x4*)(r_k + 64 * h + j2);
                        const f32x4 kraw = *(const LAS f32x4*)(lds + SC_KRAW + t2 * 256 + j2 * 4), kkn = *(const LAS f32x4*)(lds + bo + SB_KK + t2 * 256 + j2 * 4), rr = *(const LAS f32x4*)(lds + bo + SB_R + t2 * 256 + j2 * 4);
                        f32x4 dec, bb, km;
#pragma unroll
                        for (int e = 0; e < 4; ++e) { const float wp = w0v[e] + accw[e]; dec[e] = __expf(-0.60653066f * sigmoidf_(wp));
                            const float av = sigmoidf_(a0v[e] + acca[e]); km[e] = kraw[e] * (1.0f + (av - 1.0f) * kav[e]); bb[e] = kkn[e] * av; bp += rr[e] * km[e] * rkv[e]; }
                        *(LAS f32x4*)(lds + bo + SB_W + t2 * 256 + j2 * 4) = dec; *(LAS f32x4*)(lds + bo + SB_B + t2 * 256 + j2 * 4) = bb; *(LAS f32x4*)(lds + bo + SB_K + t2 * 256 + j2 * 4) = km; }
                    bp += shx(bp, lane, 16); bp += shx(bp, lane, 32);
                    if (lane < 16) *(LAS float*)(lds + SC_BON + (cc & 1) * 256 + t2 * 8 + jh * 4) = bp;
                }
                if (cc >= 2) { const int pc = cc - 2; const size_t growp = (size_t)b * SEQ + pc * SC_L; const int t = ptid >> 3, seg = ptid & 7;
                    { const f32x4 yv_ = *(const LAS f32x4*)(lds + SC_Y + (pc & 1) * 4096 + t * 128 + seg * 16); u32x2 yw_; yw_.x = pk2(yv_.x, yv_.y); yw_.y = pk2(yv_.z, yv_.w); *(u32x2*)(ys + (growp + t) * 512 + 64 * h + 32 * half + 4 * seg) = yw_; } }
                if (cc >= 1 && half == 0 && ptid < 32) { const int pc = cc - 1; const f32x2 bq = *(const LAS f32x2*)(lds + SC_BON + (pc & 1) * 256 + ptid * 8);
                    bong[((size_t)b * SEQ + pc * SC_L + ptid) * 8 + h] = bq.x + bq.y; }
                __syncthreads();
            }
        } else {
            const int rl = wave * 8 + (lane >> 3), cgp = lane & 7, rowg = half * 32 + rl;
            f32x2 s0 = {0.f, 0.f}, s1 = {0.f, 0.f}, s2 = {0.f, 0.f}, s3 = {0.f, 0.f};
            __syncthreads();
            for (int c = 0; c < SEQ / SC_L; ++c) {
                const int bo = (c & 1) * SB_SIZE; const LAS unsigned char* vb = lds + bo + cgp * 32; const LAS unsigned char* vrow = lds + bo + SB_V + rowg * 4;
#define SC_LOADV(V, t) do { V.kA = *(const LAS f32x4*)(vb + SB_KK + (t) * 256); V.kB = *(const LAS f32x4*)(vb + SB_KK + (t) * 256 + 16); V.wA = *(const LAS f32x4*)(vb + SB_W + (t) * 256); V.wB = *(const LAS f32x4*)(vb + SB_W + (t) * 256 + 16); \
        V.bA = *(const LAS f32x4*)(vb + SB_B + (t) * 256); V.bB = *(const LAS f32x4*)(vb + SB_B + (t) * 256 + 16); V.cA = *(const LAS f32x4*)(vb + SB_K + (t) * 256); V.cB = *(const LAS f32x4*)(vb + SB_K + (t) * 256 + 16); \
        V.rA = *(const LAS f32x4*)(vb + SB_R + (t) * 256); V.rB = *(const LAS f32x4*)(vb + SB_R + (t) * 256 + 16); V.vv = *(const LAS float*)(vrow + (t) * 256); } while (0)
#define SB_ __builtin_amdgcn_sched_barrier(0)
#define SC_LD1(L, f, OFF, tl) L.f = *(const LAS f32x4*)(vb + (OFF) + (tl) * 256)
#define SC_STEPF(C, L, tl, jprev) do { \
        const f32x2 vv2 = {C.vv, C.vv}; f32x2 p, vk0, vk1, vk2, vk3, t0, t1, t2, t3, q; float pa; \
        p = s0 * (f32x2){C.kA.x, C.kA.y}; SB_; vk0 = vv2 * (f32x2){C.cA.x, C.cA.y}; SB_; qprev += dppf<0xB1>(qprev); SB_; \
        p = __builtin_elementwise_fma(s1, (f32x2){C.kA.z, C.kA.w}, p); SB_; vk1 = vv2 * (f32x2){C.cA.z, C.cA.w}; SB_; qprev += dppf<0x4E>(qprev); SB_; \
        p = __builtin_elementwise_fma(s2, (f32x2){C.kB.x, C.kB.y}, p); SB_; vk2 = vv2 * (f32x2){C.cB.x, C.cB.y}; SB_; qprev += dppf<0x141>(qprev); SB_; \
        p = __builtin_elementwise_fma(s3, (f32x2){C.kB.z, C.kB.w}, p); SB_; vk3 = vv2 * (f32x2){C.cB.z, C.cB.w}; SB_; yk = (cgp == (jprev)) ? qprev : yk; SB_; \
        pa = p.x + p.y; SB_; \
        SC_LD1(L, kA, SB_KK, tl); SB_; SC_LD1(L, kB, SB_KK + 16, tl); SB_; pa += dppf<0xB1>(pa); SB_; \
        SC_LD1(L, wA, SB_W, tl); SB_; SC_LD1(L, wB, SB_W + 16, tl); SB_; pa += dppf<0x4E>(pa); SB_; \
        SC_LD1(L, bA, SB_B, tl); SB_; SC_LD1(L, bB, SB_B + 16, tl); SB_; pa += dppf<0x141>(pa); SB_; \
        { const float sa = -pa; const f32x2 sa2 = {sa, sa}; \
          t0 = __builtin_elementwise_fma(sa2, (f32x2){C.bA.x, C.bA.y}, vk0); SB_; t1 = __builtin_elementwise_fma(sa2, (f32x2){C.bA.z, C.bA.w}, vk1); SB_; \
          t2 = __builtin_elementwise_fma(sa2, (f32x2){C.bB.x, C.bB.y}, vk2); SB_; t3 = __builtin_elementwise_fma(sa2, (f32x2){C.bB.z, C.bB.w}, vk3); SB_; } \
        s0 = __builtin_elementwise_fma(s0, (f32x2){C.wA.x, C.wA.y}, t0); SB_; s1 = __builtin_elementwise_fma(s1, (f32x2){C.wA.z, C.wA.w}, t1); SB_; \
        s2 = __builtin_elementwise_fma(s2, (f32x2){C.wB.x, C.wB.y}, t2); SB_; s3 = __builtin_elementwise_fma(s3, (f32x2){C.wB.z, C.wB.w}, t3); SB_; \
        q = s0 * (f32x2){C.rA.x, C.rA.y}; SB_; SC_LD1(L, cA, SB_K, tl); SB_; \
        q = __builtin_elementwise_fma(s1, (f32x2){C.rA.z, C.rA.w}, q); SB_; SC_LD1(L, cB, SB_K + 16, tl); SB_; \
        q = __builtin_elementwise_fma(s2, (f32x2){C.rB.x, C.rB.y}, q); SB_; SC_LD1(L, rA, SB_R, tl); SB_; \
        q = __builtin_elementwise_fma(s3, (f32x2){C.rB.z, C.rB.w}, q); SB_; SC_LD1(L, rB, SB_R + 16, tl); SB_; L.vv = *(const LAS float*)(vrow + (tl) * 256); SB_; \
        qprev = q.x + q.y; SB_; } while (0)
                StepVec V0, V1, V2; SC_LOADV(V0, 0); SC_LOADV(V1, 1); float yk = 0.f, qprev = 0.f;
#pragma unroll
                for (int t = 0; t < 32; ++t) {
                    switch (t % 3) { case 0: SC_STEPF(V0, V2, (t + 2) & 31, (t + 7) & 7); break; case 1: SC_STEPF(V1, V0, (t + 2) & 31, (t + 7) & 7); break; default: SC_STEPF(V2, V1, (t + 2) & 31, (t + 7) & 7); break; }
                    if ((t & 7) == 0 && t > 0) { *(LAS float*)(lds + SC_Y + (c & 1) * 4096 + ((t - 8) + cgp) * 128 + rl * 4) = yk; }
                    SB_; }
                { const float y31 = sum8(qprev); yk = (cgp == 7) ? y31 : yk; *(LAS float*)(lds + SC_Y + (c & 1) * 4096 + (24 + cgp) * 128 + rl * 4) = yk; }
                __syncthreads();
            }
        }
        if (wave >= 4) { const int pc = SEQ / SC_L - 1, ptid = tid - 256; const size_t growp = (size_t)b * SEQ + pc * SC_L; const int t = ptid >> 3, seg = ptid & 7;
            { const f32x4 yv_ = *(const LAS f32x4*)(lds + SC_Y + (pc & 1) * 4096 + t * 128 + seg * 16); u32x2 yw_; yw_.x = pk2(yv_.x, yv_.y); yw_.y = pk2(yv_.z, yv_.w); *(u32x2*)(ys + (growp + t) * 512 + 64 * h + 32 * half + 4 * seg) = yw_; } }
        __syncthreads();
    }
}

#define LERP4(cur, prv, m) (f32x4){ bflo(cur.x) + (bflo(prv.x) - bflo(cur.x)) * m.x, bfhi(cur.x) + (bfhi(prv.x) - bfhi(cur.x)) * m.y, bflo(cur.y) + (bflo(prv.y) - bflo(cur.y)) * m.z, bfhi(cur.y) + (bfhi(prv.y) - bfhi(cur.y)) * m.w }
constexpr int PZ_STAT = 0, PZ_ZT = 1024, PZ_WM = PZ_ZT + 128 * 272, PZ_SG = PZ_WM + 128 * 272;
static_assert(PZ_SG + 128 * 272 <= LDS_BYTES, "post LDS");

__device__ __forceinline__ void post_phase(const Args& a, int li, LAS unsigned char* lds) {
    unsigned char* wsl = a.ws; asm volatile("" : "+s"(wsl));
    int tid_ = threadIdx.x; asm volatile("" : "+v"(tid_)); const int tid = tid_, lane = tid & 63, wave = __builtin_amdgcn_readfirstlane(tid >> 6);
    const bf16* proj = (const bf16*)(wsl + WS_PROJ); const bf16* ys = (const bf16*)(wsl + WS_YS); const float* bong = (const float*)(wsl + WS_BON);
    bf16* ycat = (bf16*)(wsl + WS_YCAT);
    const float* mu = a.in[5] + li * P_A; const float* lnx_g = a.in[14] + li * 512; const float* lnx_b = a.in[15] + li * 512;
    const float* bn_g = a.in[16] + li * 512; const float* bn_b = a.in[17] + li * 512; const float* sp_b = a.in[19] + li * 512;
    const bf16* spw = (const bf16*)(wsl + WS_SPW) + (size_t)li * 4 * 128 * 128; const bf16* gupt = (const bf16*)(wsl + WS_GUPT) + (size_t)li * 512 * 128;
    const int n16 = lane & 15, q4 = lane >> 4;
    for (int unit = blockIdx.x; unit < NT / 128; unit += gridDim.x) {
        const size_t t0 = (size_t)unit * 128; const int p0 = (int)(t0 & (SEQ - 1));
        { u32x4 zw[16];
#pragma unroll
          for (int r = 0; r < 16; ++r) zw[r] = *(const u32x4*)(proj + (t0 + wave * 16 + r) * P_EVEN + 2304 + 8 * lane);
#pragma unroll
          for (int r = 0; r < 16; ++r) { const int t = wave * 16 + r; const u32x4 w = zw[r];
            const float x0 = bflo(w.x), x1 = bfhi(w.x), x2 = bflo(w.y), x3 = bfhi(w.y), x4 = bflo(w.z), x5 = bfhi(w.z), x6 = bflo(w.w), x7 = bfhi(w.w);
            float s = ((x0 + x1) + (x2 + x3)) + ((x4 + x5) + (x6 + x7)), qq = ((x0 * x0 + x1 * x1) + (x2 * x2 + x3 * x3)) + ((x4 * x4 + x5 * x5) + (x6 * x6 + x7 * x7));
            s = wave_sum(s); qq = wave_sum(qq); const float mean = s * (1.f / 512.f), var = fmaxf(qq * (1.f / 512.f) - mean * mean, 0.f);
            if (lane == 0) *(LAS f32x2*)(lds + PZ_STAT + t * 8) = (f32x2){mean, 1.0f / sqrtf(var + 1e-5f)}; } }
        { const int t = tid >> 2, seg = tid & 3; const bf16* rp = proj + (t0 + t) * P_EVEN + 1664 + 32 * seg; const bool hasprev = (p0 + t) > 0;
#pragma unroll
          for (int v = 0; v < 4; ++v) { const u32x4 cw = *(const u32x4*)(rp + 8 * v); u32x4 pw = {0u, 0u, 0u, 0u}; if (hasprev) pw = *(const u32x4*)(rp - P_EVEN + 8 * v);
              const f32x4 m0 = *(const f32x4*)(mu + 1664 + 32 * seg + 8 * v), m1 = *(const f32x4*)(mu + 1664 + 32 * seg + 8 * v + 4);
              float x[8] = { bflo(cw.x), bfhi(cw.x), bflo(cw.y), bfhi(cw.y), bflo(cw.z), bfhi(cw.z), bflo(cw.w), bfhi(cw.w) };
              const float p[8] = { bflo(pw.x), bfhi(pw.x), bflo(pw.y), bfhi(pw.y), bflo(pw.z), bfhi(pw.z), bflo(pw.w), bfhi(pw.w) };
              const float mm[8] = { m0.x, m0.y, m0.z, m0.w, m1.x, m1.y, m1.z, m1.w };
#pragma unroll
              for (int e = 0; e < 8; ++e) x[e] = sigmoidf_(x[e] + (p[e] - x[e]) * mm[e]);
              u32x4 o; o.x = pk2(x[0], x[1]); o.y = pk2(x[2], x[3]); o.z = pk2(x[4], x[5]); o.w = pk2(x[6], x[7]);
              *(LAS u32x4*)(lds + PZ_SG + t * 272 + (32 * seg + 8 * v) * 2) = o; } }
        __syncthreads();
        for (int g = 0; g < 4; ++g) {
            { const int cp = tid & 63, tp = tid >> 6; const int c0 = 128 * g + 2 * cp; const float g0 = bn_g[c0], g1 = bn_g[c0 + 1], b0 = bn_b[c0], b1 = bn_b[c0 + 1];
              unsigned wa_[8], wb_[8];
#pragma unroll
              for (int it = 0; it < 8; ++it) { const int tt = tp + 8 * it; wa_[it] = *(const unsigned*)(proj + (t0 + 2 * tt) * P_EVEN + 2304 + c0); wb_[it] = *(const unsigned*)(proj + (t0 + 2 * tt + 1) * P_EVEN + 2304 + c0); }
#pragma unroll
              for (int it = 0; it < 8; ++it) { const int tt = tp + 8 * it; const unsigned wa = wa_[it], wb = wb_[it];
                  const f32x2 sa = *(const LAS f32x2*)(lds + PZ_STAT + (2 * tt) * 8), sb = *(const LAS f32x2*)(lds + PZ_STAT + (2 * tt + 1) * 8);
                  const float za0 = (bflo(wa) - sa.x) * sa.y * g0 + b0, za1 = (bfhi(wa) - sa.x) * sa.y * g1 + b1, zb0 = (bflo(wb) - sb.x) * sb.y * g0 + b0, zb1 = (bfhi(wb) - sb.x) * sb.y * g1 + b1;
                  *(LAS unsigned*)(lds + PZ_ZT + (2 * cp) * 272 + (2 * tt) * 2) = pk2(za0, zb0); *(LAS unsigned*)(lds + PZ_ZT + (2 * cp + 1) * 272 + (2 * tt) * 2) = pk2(za1, zb1); } }
            { const int i = tid >> 2, seg = tid & 3; const bf16* src = spw + (size_t)(g * 128 + i) * 128 + 32 * seg;
#pragma unroll
              for (int v = 0; v < 4; ++v) *(LAS u32x4*)(lds + PZ_WM + i * 272 + (32 * seg + 8 * v) * 2) = *(const u32x4*)(src + 8 * v); }
            __syncthreads();
            { const int db = wave; bf16x8 Af[4];
#pragma unroll
              for (int kk = 0; kk < 4; ++kk) Af[kk] = *(const LAS bf16x8*)(lds + PZ_ZT + (16 * db + n16) * 272 + (32 * kk + 8 * q4) * 2);
              u32x2 uws[8]; float biases[8];
#pragma unroll
              for (int ib = 0; ib < 8; ++ib) { const int i = 16 * ib + n16; uws[ib] = *(const u32x2*)(proj + (t0 + i) * P_EVEN + 1792 + 128 * g + 16 * db + 4 * q4); biases[ib] = sp_b[g * 128 + i]; }
#pragma unroll
              for (int ib = 0; ib < 8; ++ib) { f32x4 acc = {0.f, 0.f, 0.f, 0.f};
#pragma unroll
                  for (int kk = 0; kk < 4; ++kk) if (32 * kk <= 16 * ib + 15) { const bf16x8 Bf = *(const LAS bf16x8*)(lds + PZ_WM + (16 * ib + n16) * 272 + (32 * kk + 8 * q4) * 2);
                      acc = __builtin_amdgcn_mfma_f32_16x16x32_bf16(Af[kk], Bf, acc, 0, 0, 0); }
                  const int i = 16 * ib + n16, c = 128 * g + 16 * db + 4 * q4; const float bias = biases[ib];
                  const u32x2 uw = uws[ib];
                  u32x2 o; o.x = pk2(bflo(uw.x) * (acc[0] + bias), bfhi(uw.x) * (acc[1] + bias)); o.y = pk2(bflo(uw.y) * (acc[2] + bias), bfhi(uw.y) * (acc[3] + bias));
                  *(u32x2*)(ycat + (t0 + i) * DM + 512 + c) = o; } }
            __syncthreads();
        }
        { const int h = wave; bf16x8 Ag[4][4];
#pragma unroll
          for (int cb = 0; cb < 4; ++cb)
#pragma unroll
              for (int kk = 0; kk < 4; ++kk) Ag[cb][kk] = *(const bf16x8*)(gupt + (size_t)(64 * h + 16 * cb + n16) * 128 + 32 * kk + 8 * q4);
          for (int tb = 0; tb < 8; ++tb) {
              f32x4 G[4];
#pragma unroll
              for (int cb = 0; cb < 4; ++cb) G[cb] = (f32x4){0.f, 0.f, 0.f, 0.f};
#pragma unroll
              for (int kk = 0; kk < 4; ++kk) { const bf16x8 Bf = *(const LAS bf16x8*)(lds + PZ_SG + (16 * tb + n16) * 272 + (32 * kk + 8 * q4) * 2);
#pragma unroll
                  for (int cb = 0; cb < 4; ++cb) G[cb] = __builtin_amdgcn_mfma_f32_16x16x32_bf16(Ag[cb][kk], Bf, G[cb], 0, 0, 0); }
              const int tl = 16 * tb + n16; const size_t tt = t0 + tl; const bool hasprev = (p0 + tl) > 0;
              f32x4 y[4]; float s = 0.f;
#pragma unroll
              for (int cb = 0; cb < 4; ++cb) { { const u32x2 yw_ = *(const u32x2*)(ys + tt * 512 + 64 * h + 16 * cb + 4 * q4); y[cb] = (f32x4){bflo(yw_.x), bfhi(yw_.x), bflo(yw_.y), bfhi(yw_.y)}; } s += (y[cb].x + y[cb].y) + (y[cb].z + y[cb].w); }
              s += shx(s, lane, 16); s += shx(s, lane, 32); const float mean = s * (1.f / 64.f); float qq = 0.f;
#pragma unroll
              for (int cb = 0; cb < 4; ++cb) { y[cb] = y[cb] - mean; qq += (y[cb].x * y[cb].x + y[cb].y * y[cb].y) + (y[cb].z * y[cb].z + y[cb].w * y[cb].w); }
              qq += shx(qq, lane, 16); qq += shx(qq, lane, 32); const float rstd = 1.0f / sqrtf(qq * (1.f / 64.f) + 64e-5f);
              const float bon = bong[tt * 8 + h];
#pragma unroll
              for (int cb = 0; cb < 4; ++cb) { const int c = 64 * h + 16 * cb + 4 * q4;
                  const u32x2 cv = *(const u32x2*)(proj + tt * P_EVEN + 1024 + c); u32x2 pv = {0u, 0u}; if (hasprev) pv = *(const u32x2*)(proj + (tt - 1) * P_EVEN + 1024 + c);
                  const f32x4 m = *(const f32x4*)(mu + 1024 + c), lg = *(const f32x4*)(lnx_g + c), lb = *(const f32x4*)(lnx_b + c);
                  const f32x4 v4 = LERP4(cv, pv, m);
                  const f32x4 o = ((y[cb] * rstd) * lg + lb + v4 * bon) * G[cb];
                  u32x2 w; w.x = pk2(o.x, o.y); w.y = pk2(o.z, o.w); *(u32x2*)(ycat + tt * DM + c) = w; }
          } }
        __syncthreads();
    }
}

constexpr int OM_GL = 0, OM_CV = 62 * 1024;
static_assert(OM_CV + 32 * 2048 <= LDS_BYTES, "odd LDS");
template <int WIN> __device__ __forceinline__ void pool_rows(const bf16* proj, bf16* ycat, size_t t0, int p0, int c) {
    float x[47];
#pragma unroll
    for (int i = 0; i < 47; ++i) { const int p = p0 - 15 + i; x[i] = (i >= 16 - WIN) ? ((p >= 0) ? bf1(proj[(t0 - 15 + i) * P_ODD + 1024 + c]) : 0.f) : 0.f; }
#pragma unroll
    for (int t = 0; t < 32; ++t) { float s = 0.f;
#pragma unroll
        for (int k = 0; k < WIN; ++k) s += x[15 + t - k];
        const int p = p0 + t; const float cnt = (float)((p + 1 < WIN) ? p + 1 : WIN);
        ycat[(t0 + t) * DM + 512 + c] = (bf16)f2bf(s / cnt - x[15 + t]); }
}
__device__ __forceinline__ void oddmix_phase(const Args& a, int li, LAS unsigned char* lds) {
    unsigned char* wsl = a.ws; asm volatile("" : "+s"(wsl));
    int tid_ = threadIdx.x; asm volatile("" : "+v"(tid_)); const int tid = tid_, lane = tid & 63, wave = __builtin_amdgcn_readfirstlane(tid >> 6);
    const bf16* proj = (const bf16*)(wsl + WS_PROJ); bf16* ycat = (bf16*)(wsl + WS_YCAT);
    const float* conv_w = a.in[22] + li * 31 * 512; const float* conv_b = a.in[23] + li * 512; const float* cn_g = a.in[24] + li * 512; const float* cn_b = a.in[25] + li * 512;
    float cw[31];
#pragma unroll
    for (int k = 0; k < 31; ++k) cw[k] = conv_w[k * 512 + tid];
    const float cb = conv_b[tid];
    f32x4 g0 = *(const f32x4*)(cn_g + 8 * lane), g1 = *(const f32x4*)(cn_g + 8 * lane + 4), b0 = *(const f32x4*)(cn_b + 8 * lane), b1 = *(const f32x4*)(cn_b + 8 * lane + 4);
    for (int unit = blockIdx.x; unit < NT / 32; unit += gridDim.x) {
        const size_t t0 = (size_t)unit * 32; const int p0 = (int)(t0 & (SEQ - 1));
        { u32x4 gv_[8], gg_[8];
#pragma unroll
          for (int it = 0; it < 8; ++it) { const int task = tid + it * NTHREADS; const int rr = task >> 6, seg = task & 63; const int p = p0 - 30 + rr; gv_[it] = (u32x4){0u, 0u, 0u, 0u}; gg_[it] = (u32x4){0u, 0u, 0u, 0u};
              if (task < 62 * 64 && p >= 0) { const bf16* rp = proj + (t0 + rr - 30) * P_ODD + 8 * seg; gv_[it] = *(const u32x4*)rp; gg_[it] = *(const u32x4*)(rp + 512); } }
#pragma unroll
          for (int it = 0; it < 8; ++it) { const int task = tid + it * NTHREADS; const int rr = task >> 6, seg = task & 63; const u32x4 v = gv_[it], gt = gg_[it]; u32x4 o;
              o.x = pk2(bflo(v.x) * sigmoidf_(bflo(gt.x)), bfhi(v.x) * sigmoidf_(bfhi(gt.x))); o.y = pk2(bflo(v.y) * sigmoidf_(bflo(gt.y)), bfhi(v.y) * sigmoidf_(bfhi(gt.y)));
              o.z = pk2(bflo(v.z) * sigmoidf_(bflo(gt.z)), bfhi(v.z) * sigmoidf_(bfhi(gt.z))); o.w = pk2(bflo(v.w) * sigmoidf_(bflo(gt.w)), bfhi(v.w) * sigmoidf_(bfhi(gt.w)));
              if (task < 62 * 64) *(LAS u32x4*)(lds + OM_GL + rr * 1024 + seg * 16) = o; } }
        __syncthreads();
#pragma unroll 1
        for (int ob = 0; ob < 4; ++ob) { float xin[38];
#pragma unroll
            for (int i = 0; i < 38; ++i) xin[i] = bf1(*(const LAS bf16*)(lds + OM_GL + (ob * 8 + i) * 1024 + tid * 2));
#pragma unroll
            for (int t = 0; t < 8; ++t) { float acc = cb;
#pragma unroll
                for (int k = 0; k < 31; ++k) acc += cw[k] * xin[t + k];
                *(LAS float*)(lds + OM_CV + (ob * 8 + t) * 2048 + tid * 4) = acc; } }
        __syncthreads();
#pragma unroll 1
        for (int r = 0; r < 4; ++r) { const int t = wave * 4 + r; f32x4 v0 = *(const LAS f32x4*)(lds + OM_CV + t * 2048 + lane * 32), v1 = *(const LAS f32x4*)(lds + OM_CV + t * 2048 + lane * 32 + 16);
            float s = ((v0.x + v0.y) + (v0.z + v0.w)) + ((v1.x + v1.y) + (v1.z + v1.w)); s = wave_sum(s); const float mean = s * (1.f / 512.f);
            v0 = v0 - mean; v1 = v1 - mean; float qq = ((v0.x * v0.x + v0.y * v0.y) + (v0.z * v0.z + v0.w * v0.w)) + ((v1.x * v1.x + v1.y * v1.y) + (v1.z * v1.z + v1.w * v1.w));
            qq = wave_sum(qq); const float rstd = 1.0f / sqrtf(qq * (1.f / 512.f) + 1e-5f);
            v0 = v0 * rstd * g0 + b0; v1 = v1 * rstd * g1 + b1;
            u32x4 o; o.x = pk2(v0.x * sigmoidf_(v0.x), v0.y * sigmoidf_(v0.y)); o.y = pk2(v0.z * sigmoidf_(v0.z), v0.w * sigmoidf_(v0.w));
            o.z = pk2(v1.x * sigmoidf_(v1.x), v1.y * sigmoidf_(v1.y)); o.w = pk2(v1.z * sigmoidf_(v1.z), v1.w * sigmoidf_(v1.w));
            *(u32x4*)(ycat + (t0 + t) * DM + 8 * lane) = o; }
        { const int gi = wave >> 1;
          if (gi == 0) pool_rows<2>(proj, ycat, t0, p0, tid); else if (gi == 1) pool_rows<4>(proj, ycat, t0, p0, tid); else if (gi == 2) pool_rows<8>(proj, ycat, t0, p0, tid); else pool_rows<16>(proj, ycat, t0, p0, tid); }
    }
    __syncthreads();
}

#define REPEAT(n) _Pragma("unroll 1") for (int rep_ = 0; rep_ < (n); ++rep_)
#define REP_SYNC 1
#define REP_PREP 1
typedef __attribute__((address_space(1))) unsigned gu32;
#define XB_TMO      128
#define XB_XCNT(j)  (256  + 64 * (j))
#define XB_XSUB(j)  (1280 + 64 * (j))
#define XB_XGEN(j)  (2304 + 64 * (j))
#define XB_TOP      3328
#define XB_TOPGEN   3392
#define XCD_BAR_WORDS 3456
#define XB_SPIN_CAP (1u << 18)

__device__ __forceinline__ unsigned xb_ld(unsigned* p)              { return __hip_atomic_load(p, __ATOMIC_RELAXED, __HIP_MEMORY_SCOPE_AGENT); }
__device__ __forceinline__ unsigned xb_add(unsigned* p, unsigned v) { return __hip_atomic_fetch_add(p, v, __ATOMIC_RELAXED, __HIP_MEMORY_SCOPE_AGENT); }
__device__ __forceinline__ unsigned xb_xcc_id() { return (unsigned)__builtin_amdgcn_s_getreg((3 << 11) | 20) & 0xFu; }
#define XB_SPIN(cond, bar) do { unsigned _sp = 0; while (cond) { __builtin_amdgcn_s_sleep(1); \
    if ((++_sp & 255u) == 0u) { if (xb_ld(&(bar)[XB_TMO])) break; if (_sp > XB_SPIN_CAP) { atomicAdd(&(bar)[XB_TMO], 1u); break; } } } } while (0)

struct XcdBarrier {
    unsigned* bar; unsigned x;
    volatile LAS unsigned* st;
};

__device__ __forceinline__ XcdBarrier xcd_barrier_post(unsigned* bar, volatile LAS unsigned* st) {
    XcdBarrier b; b.bar = bar; b.x = xb_xcc_id(); b.st = st;
    if (threadIdx.x == 0) (void)xb_add(&bar[XB_XCNT(b.x)], 1u);
    return b;
}
__device__ __forceinline__ void xcd_barrier_complete(unsigned* bar, unsigned x, unsigned& nloc, unsigned& nx) {
    const unsigned G = gridDim.x * gridDim.y * gridDim.z;
    unsigned sum, cnt, mine, sp = 0u;
    for (;;) {
        sum = 0u; cnt = 0u; mine = 0u;
#pragma unroll
        for (unsigned j = 0; j < 16; ++j) { const unsigned c = xb_ld(&bar[XB_XCNT(j)]); sum += c; cnt += (c > 0u) ? 1u : 0u; mine = (j == x) ? c : mine; }
        if (sum == G) break;
        __builtin_amdgcn_s_sleep(1);
        if ((++sp & 255u) == 0u) { if (xb_ld(&bar[XB_TMO])) break; if (sp > XB_SPIN_CAP) { atomicAdd(&bar[XB_TMO], 1u); break; } }
    }
    nloc = mine > 0u ? mine : 1u; nx = cnt > 0u ? cnt : 1u;
}

__device__ __forceinline__ void xcd_barrier(const XcdBarrier& b) {
    asm volatile("s_waitcnt vmcnt(0)" ::: "memory");
    __syncthreads();
    if (threadIdx.x == 0) {
        unsigned* bar = b.bar;
        __builtin_amdgcn_s_waitcnt(0);
        unsigned nloc = b.st[0], nx = b.st[1];
        if (nloc == 0u) { xcd_barrier_complete(bar, b.x, nloc, nx); b.st[0] = nloc; b.st[1] = nx; }
        const unsigned old = xb_add(&bar[XB_XSUB(b.x)], 1u);
        const unsigned gen = old / nloc;
        if (old + 1u == (gen + 1u) * nloc) {
            __builtin_amdgcn_fence(__ATOMIC_RELEASE, "agent");
            asm volatile("s_waitcnt vmcnt(0)" ::: "memory");
            const unsigned og = xb_add(&bar[XB_TOP], 1u);
            const unsigned tg = og / nx;
            if (og + 1u == (tg + 1u) * nx) xb_add(&bar[XB_TOPGEN], 1u);
            else XB_SPIN(xb_ld(&bar[XB_TOPGEN]) == tg, bar);
            __builtin_amdgcn_fence(__ATOMIC_ACQUIRE, "agent");
            xb_add(&bar[XB_XGEN(b.x)], 1u);
            asm volatile("s_waitcnt vmcnt(0)" ::: "memory");
        } else {
            XB_SPIN(xb_ld(&bar[XB_XGEN(b.x)]) == gen, bar);
            __builtin_amdgcn_fence(__ATOMIC_ACQUIRE, "agent");
            asm volatile("s_waitcnt vmcnt(0)" ::: "memory");
        }
    }
    __syncthreads();
}

#define GSYNC() do { _Pragma("unroll 1") for (int rs_ = 0; rs_ < REP_SYNC; ++rs_) xcd_barrier(xbar); } while (0)
#define REP_NORM 1
#define REP_G1 1
#define REP_SCAN 1
#define REP_POST 1
#define REP_ODD 1
#define REP_G3 1
__global__ void __launch_bounds__(NTHREADS, 2) trunk_fwd(Args args) {
    extern __shared__ __attribute__((aligned(16))) unsigned char lds_raw[];
    LAS unsigned char* lds = (LAS unsigned char*)lds_raw;
    cg::grid_group grid = cg::this_grid();
    unsigned char* ws = args.ws; const int G = gridDim.x;
    bf16* HN = (bf16*)(ws + WS_HN); bf16* PROJ = (bf16*)(ws + WS_PROJ); bf16* YCAT = (bf16*)(ws + WS_YCAT); bf16* HB = (bf16*)(ws + WS_H);
    if (threadIdx.x < 16) ((LAS unsigned*)(lds + XB_LDS_OFF))[threadIdx.x] = 0u;
    __syncthreads();
    const XcdBarrier xbar = xcd_barrier_post((unsigned*)(ws + WS_CTL), (volatile LAS unsigned*)(lds + XB_LDS_OFF));
    REPEAT(REP_PREP) { prep_phase(args, lds); }
    rmsnorm_phase(args.in[0], nullptr, args.in[1], HN, HB);
    if (args.out == nullptr) grid.sync();
    GSYNC();
#pragma unroll 1
    for (int layer = 0; layer < DEPTH; ++layer) {
        const int li = layer >> 1; const bool even = (layer & 1) == 0;
        const float* hin = (layer == 0) ? args.in[0] : nullptr;
        asm volatile("" : "+s"(HN), "+s"(PROJ), "+s"(YCAT), "+s"(ws), "+s"(hin), "+s"(HB));
        if (even) {
            REPEAT(REP_G1) { pg8::Gemm g{HN, (const bf16*)(ws + WS_EVIN) + (size_t)li * P_EVEN * DM, NT, P_EVEN, DM}; pg8::StaticOrder S; S.init(NT, P_EVEN, G, (int)blockIdx.x);
              pg8::EpiProj E{PROJ, P_EVEN, 7}; pg8::gemm_phase<pg8::EpiProj, pg8::StaticOrder, true, true>(lds, g, S, E);
            GSYNC(); }
            REPEAT(REP_SCAN) { scan_phase(args, li, lds);
            GSYNC(); }
            REPEAT(REP_POST) { post_phase(args, li, lds);
            GSYNC(); }
        } else {
            REPEAT(REP_G1) { pg8::Gemm g{HN, (const bf16*)(ws + WS_ODIN) + (size_t)li * P_ODD * DM, NT, P_ODD, DM}; pg8::StaticOrder S; S.init(NT, P_ODD, G, (int)blockIdx.x);
              pg8::EpiProj E{PROJ, P_ODD, 1000}; pg8::gemm_phase<pg8::EpiProj, pg8::StaticOrder, true, true>(lds, g, S, E);
            GSYNC(); }
            REPEAT(REP_ODD) { oddmix_phase(args, li, lds);
            GSYNC(); }
        }
        { pg8::Gemm g{YCAT, (const bf16*)(ws + WS_WOUT) + (size_t)layer * DM * DM, NT, DM, DM}; pg8::StaticOrder S; S.init(NT, DM, G, (int)blockIdx.x);
          unsigned* xb = (unsigned*)(ws + WS_XB); unsigned* pc = (unsigned*)(ws + WS_CNT); const float* gn = args.in[2] + layer * DM; const unsigned tg = 16u * (unsigned)(2 * layer + 1);
          { pg8::EpiResX<false, false> E{nullptr, HB, HB, HN, nullptr, gn, DM, xb, pc, tg, lds}; pg8::gemm_phase<pg8::EpiResX<false, false>, pg8::StaticOrder, true, true>(lds, g, S, E); } }
        GSYNC();
        REPEAT(REP_G3) { pg8::Gemm g{HN, (const bf16*)(ws + WS_GU) + (size_t)layer * 2 * FF * DM, NT, 2 * FF, DM}; pg8::StaticOrder S; S.init(NT, 2 * FF, G, (int)blockIdx.x);
          pg8::EpiSwiGLU E{PROJ, FF}; pg8::gemm_phase<pg8::EpiSwiGLU, pg8::StaticOrder, true, true>(lds, g, S, E);
        GSYNC(); }
        { pg8::Gemm g{PROJ, (const bf16*)(ws + WS_DN) + (size_t)layer * DM * FF, NT, DM, FF}; pg8::StaticOrder S; S.init(NT, DM, G, (int)blockIdx.x);
          unsigned* xb = (unsigned*)(ws + WS_XB); unsigned* pc = (unsigned*)(ws + WS_CNT); const unsigned tg = 16u * (unsigned)(2 * layer + 2);
          if (layer == DEPTH - 1) { pg8::EpiResX<false, true> E{nullptr, HB, nullptr, nullptr, args.out, args.in[3], DM, xb, pc, tg, lds}; pg8::gemm_phase<pg8::EpiResX<false, true>, pg8::StaticOrder, true, true>(lds, g, S, E); }
          else { pg8::EpiResX<false, false> E{nullptr, HB, HB, HN, nullptr, args.in[1] + (layer + 1) * DM, DM, xb, pc, tg, lds}; pg8::gemm_phase<pg8::EpiResX<false, false>, pg8::StaticOrder, true, true>(lds, g, S, E); } }
        GSYNC();
    }
}

extern "C" void kernel_launch(void* const* d_in, const int* in_sizes, int n_in, void* d_out, int out_size, void* d_ws, size_t ws_size, hipStream_t stream) {
    static int grid = 0;
    if (grid == 0) {
        if (n_in != 32 || out_size != NT * DM || ws_size < WS_END) { fprintf(stderr, "kernel_launch: unexpected shapes (n_in %d out %d ws %zu)\n", n_in, out_size, ws_size); grid = -1; return; }
        int dev = 0, cus = 0, per_cu = 0;
        hipGetDevice(&dev); hipDeviceGetAttribute(&cus, hipDeviceAttributeMultiprocessorCount, dev);
        if (hipFuncSetAttribute((const void*)trunk_fwd, hipFuncAttributeMaxDynamicSharedMemorySize, LDS_BYTES) != hipSuccess) { fprintf(stderr, "kernel_launch: hipFuncSetAttribute failed\n"); grid = -1; return; }
        if (hipOccupancyMaxActiveBlocksPerMultiprocessor(&per_cu, (const void*)trunk_fwd, NTHREADS, LDS_BYTES) != hipSuccess || per_cu < 1) { fprintf(stderr, "kernel_launch: occupancy query says %d\n", per_cu); per_cu = 1; }
        (void)hipGetLastError();
        grid = cus * 1;
    }
    if (grid < 0) return;
    if (hipMemsetAsync((char*)d_ws + WS_CTL, 0, 131072, stream) != hipSuccess) { fprintf(stderr, "kernel_launch: memset of the control words failed\n"); return; }
    Args a{};
    for (int i = 0; i < 32; ++i) a.in[i] = (const float*)d_in[i];
    a.out = (float*)d_out; a.ws = (unsigned char*)d_ws;
    void* kargs[] = { &a };
    hipError_t e = hipLaunchCooperativeKernel((const void*)trunk_fwd, dim3(grid), dim3(NTHREADS), kargs, LDS_BYTES, stream);
    if (e != hipSuccess) fprintf(stderr, "cooperative launch failed: %s (grid %d)\n", hipGetErrorString(e), grid);
}
```
